# Optimizing an MI355X kernel written in HIP

```python
import math
import jax, jax.numpy as jnp
from jax import lax
import numpy as np

D_MODEL = 1024
BATCH = 4
SEQ = 4096
DEPTH = 4

HEAD_DIM = 64
N_DIFF_HEADS = 6
DIFF_QK_DIM = HEAD_DIM // 2
N_GQA_HEADS = 6
N_GQA_KV_HEADS = 2
GQA_GROUP = N_GQA_HEADS // N_GQA_KV_HEADS
N_MEM_HEADS = 4
N_MEM = 256
GRID_W = 64
Q_BLOCK = 128
ROPE_THETA = 10000.0
NORM_EPS = 1e-6

DIFF_W = N_DIFF_HEADS * HEAD_DIM
GQA_W = N_GQA_HEADS * HEAD_DIM
GQA_KV_W = N_GQA_KV_HEADS * HEAD_DIM
MEM_W = N_MEM_HEADS * HEAD_DIM
D_MIX = DIFF_W + GQA_W + MEM_W
IN_SIZES = [DIFF_W, DIFF_W, DIFF_W, DIFF_W, GQA_W, GQA_KV_W, GQA_KV_W, GQA_W, MEM_W, MEM_W]
D_IN = sum(IN_SIZES)
IN_OFFSETS = [int(v) for v in np.cumsum(IN_SIZES)[:-1]]

kernel_name = "hybrid_diffattn_axialgqa_memxattn_encoder"


def rms_norm(x, g):
    xf = x.astype(jnp.float32)
    y = xf * lax.rsqrt(jnp.mean(xf * xf, axis=-1, keepdims=True) + NORM_EPS)
    return (y * g.astype(jnp.float32)).astype(x.dtype)


def rope_tables(pos, dim):
    inv = ROPE_THETA ** (-jnp.arange(0, dim, 2, dtype=jnp.float32) / dim)
    ang = pos.astype(jnp.float32)[:, None] * inv[None, :]
    return jnp.cos(ang), jnp.sin(ang)


def apply_rope(x, cos, sin):
    xf = x.astype(jnp.float32)
    half = xf.shape[-1] // 2
    x1, x2 = xf[..., :half], xf[..., half:]
    return jnp.concatenate([x1 * cos - x2 * sin, x2 * cos + x1 * sin], axis=-1).astype(x.dtype)


def apply_axial_rope(x, row_cs, col_cs):
    half = x.shape[-1] // 2
    return jnp.concatenate([apply_rope(x[..., :half], *row_cs),
                            apply_rope(x[..., half:], *col_cs)], axis=-1)


def diff_attention(q1, q2, k1, k2, v, lam):
    B, H, S, d = q1.shape
    nb = S // Q_BLOCK
    scale = d ** -0.5

    def blockify(q):
        return jnp.moveaxis(q.reshape(B, H, nb, Q_BLOCK, d), 2, 0)

    def one(qs):
        a, b = qs
        s1 = jnp.einsum('bhqd,bhkd->bhqk', a, k1).astype(jnp.float32) * scale
        s2 = jnp.einsum('bhqd,bhkd->bhqk', b, k2).astype(jnp.float32) * scale
        p = jax.nn.softmax(s1, axis=-1) - lam * jax.nn.softmax(s2, axis=-1)
        return jnp.einsum('bhqk,bhke->bhqe', p.astype(v.dtype), v)

    o = lax.map(one, (blockify(q1), blockify(q2)))
    return jnp.moveaxis(o, 0, 2).reshape(B, H, S, v.shape[-1])


def gqa_attention(q, k, v):
    B, Hk, G, S, d = q.shape
    nb = S // Q_BLOCK
    scale = d ** -0.5
    qb = jnp.moveaxis(q.reshape(B, Hk, G, nb, Q_BLOCK, d), 3, 0)

    def one(qblk):
        s = jnp.einsum('bhgqd,bhkd->bhgqk', qblk, k).astype(jnp.float32) * scale
        p = jax.nn.softmax(s, axis=-1)
        return jnp.einsum('bhgqk,bhkd->bhgqd', p.astype(v.dtype), v)

    o = lax.map(one, qb)
    return jnp.moveaxis(o, 0, 3).reshape(B, Hk, G, S, d)


def setup_inputs(seed: int = 0) -> dict:
    key = jax.random.key(seed)
    ks = jax.random.split(key, 14)
    f32 = jnp.float32
    n = jax.random.normal
    return {
        "x": n(ks[0], (BATCH, SEQ, D_MODEL), f32),
        "mem": n(ks[1], (BATCH, N_MEM, D_MODEL), f32),
        "pre_norm": 1.0 + 0.02 * n(ks[2], (DEPTH, D_MODEL), f32),
        "w_in": n(ks[3], (DEPTH, D_MODEL, D_IN), f32) * D_MODEL ** -0.5,
        "diff_lambda": 0.1 * n(ks[4], (DEPTH, 4, DIFF_QK_DIM), f32),
        "diff_subln": 1.0 + 0.02 * n(ks[5], (DEPTH, HEAD_DIM), f32),
        "gqa_q_norm": 1.0 + 0.02 * n(ks[6], (DEPTH, HEAD_DIM), f32),
        "gqa_k_norm": 1.0 + 0.02 * n(ks[7], (DEPTH, HEAD_DIM), f32),
        "mem_norm": 1.0 + 0.02 * n(ks[8], (DEPTH, D_MODEL), f32),
        "w_mem_kv": n(ks[9], (DEPTH, D_MODEL, 2 * MEM_W), f32) * D_MODEL ** -0.5,
        "w_out": n(ks[10], (DEPTH, D_MIX, D_MODEL), f32) * D_MIX ** -0.5,
        "post_norm": 1.0 + 0.02 * n(ks[11], (DEPTH, D_MODEL), f32),
    }


def reference(x, mem, pre_norm, w_in, diff_lambda, diff_subln, gqa_q_norm, gqa_k_norm,
              mem_norm, w_mem_kv, w_out, post_norm):
    B, S, _ = x.shape
    M = mem.shape[1]
    ROWS = S // GRID_W
    t = jnp.arange(S, dtype=jnp.int32)
    row = jnp.repeat(jnp.arange(ROWS, dtype=jnp.int32), GRID_W)
    col = jnp.tile(jnp.arange(GRID_W, dtype=jnp.int32), ROWS)
    lin_cs = rope_tables(t, DIFF_QK_DIM)
    row_cs = rope_tables(row, HEAD_DIM // 2)
    col_cs = rope_tables(col, HEAD_DIM // 2)

    for l in range(DEPTH):
        lambda_init = 0.8 - 0.6 * math.exp(-0.3 * l)
        h = rms_norm(x, pre_norm[l])
        proj = h @ w_in[l]
        (dq, dk, dv, dgate, gq, gk, gv, ggate, mq, mgate) = jnp.split(proj, IN_OFFSETS, axis=-1)

        dq = apply_rope(dq.reshape(B, S, N_DIFF_HEADS, 2, DIFF_QK_DIM).transpose(0, 2, 3, 1, 4), *lin_cs)
        dk = apply_rope(dk.reshape(B, S, N_DIFF_HEADS, 2, DIFF_QK_DIM).transpose(0, 2, 3, 1, 4), *lin_cs)
        dv = dv.reshape(B, S, N_DIFF_HEADS, HEAD_DIM).transpose(0, 2, 1, 3)
        lp = diff_lambda[l].astype(jnp.float32)
        lam = jnp.exp(jnp.sum(lp[0] * lp[1])) - jnp.exp(jnp.sum(lp[2] * lp[3])) + lambda_init
        oa = diff_attention(dq[:, :, 0], dq[:, :, 1], dk[:, :, 0], dk[:, :, 1], dv, lam)
        oa = rms_norm(oa, diff_subln[l]) * (1.0 - lambda_init)
        oa = oa.transpose(0, 2, 1, 3).reshape(B, S, DIFF_W) * jax.nn.silu(dgate)

        gq = rms_norm(gq.reshape(B, S, N_GQA_HEADS, HEAD_DIM).transpose(0, 2, 1, 3), gqa_q_norm[l])
        gq = apply_axial_rope(gq, row_cs, col_cs).reshape(B, N_GQA_KV_HEADS, GQA_GROUP, S, HEAD_DIM)
        gk = rms_norm(gk.reshape(B, S, N_GQA_KV_HEADS, HEAD_DIM).transpose(0, 2, 1, 3), gqa_k_norm[l])
        gk = apply_axial_rope(gk, row_cs, col_cs)
        gv = gv.reshape(B, S, N_GQA_KV_HEADS, HEAD_DIM).transpose(0, 2, 1, 3)
        ob = gqa_attention(gq, gk, gv).reshape(B, N_GQA_HEADS, S, HEAD_DIM)
        ob = ob.transpose(0, 2, 1, 3).reshape(B, S, GQA_W) * jax.nn.silu(ggate)

        mkv = rms_norm(mem, mem_norm[l]) @ w_mem_kv[l]
        mk, mv = jnp.split(mkv, 2, axis=-1)
        mk = mk.reshape(B, M, N_MEM_HEADS, HEAD_DIM).transpose(0, 2, 1, 3)
        mv = mv.reshape(B, M, N_MEM_HEADS, HEAD_DIM).transpose(0, 2, 1, 3)
        mq = mq.reshape(B, S, N_MEM_HEADS, HEAD_DIM).transpose(0, 2, 1, 3)
        sm = jnp.einsum('bhsd,bhmd->bhsm', mq, mk).astype(jnp.float32) * HEAD_DIM ** -0.5
        pm = jax.nn.softmax(sm, axis=-1)
        om = jnp.einsum('bhsm,bhmd->bhsd', pm.astype(mv.dtype), mv)
        om = om.transpose(0, 2, 1, 3).reshape(B, S, MEM_W) * jax.nn.silu(mgate)

        y = jnp.concatenate([oa, ob, om], axis=-1) @ w_out[l]
        x = x + rms_norm(y, post_norm[l])
    return x
```

```cpp
#include <hip/hip_runtime.h>
#include <hip/hip_cooperative_groups.h>
#include <cstdio>
#include <cstdint>
namespace cg = cooperative_groups;
#ifndef ONE_LAUNCH
#define ONE_LAUNCH 1
#endif
#define DI __device__ __forceinline__
typedef float f32x2_t __attribute__((ext_vector_type(2)));
typedef __bf16 bf16x2_t __attribute__((ext_vector_type(2)));
DI unsigned cvtpk(float lo, float hi) { f32x2_t v = {lo, hi}; bf16x2_t b = __builtin_convertvector(v, bf16x2_t); return __builtin_bit_cast(unsigned, b); }
DI float bf_lo(unsigned u) { return __uint_as_float(u << 16); }
DI float bf_hi(unsigned u) { return __uint_as_float(u & 0xffff0000u); }
constexpr float NORM_EPS = 1e-6f;
constexpr float LOG2E = 1.4426950408889634f;
constexpr float SC_D = 0.17677669529663687f * LOG2E;
constexpr float SC_G = 0.125f * LOG2E;
DI int vpos(int t) { const int k = t & 15; return (t & ~15) | (((k >> 2) & 1) << 3) | ((k >> 3) << 2) | (k & 3); }
DI int lane_now() { int l; asm volatile("v_mbcnt_lo_u32_b32 %0, -1, 0\n\tv_mbcnt_hi_u32_b32 %0, -1, %0" : "=v"(l)); return l; }
typedef float f32x4 __attribute__((ext_vector_type(4)));
namespace pg8 {
#define PG8_LAS __attribute__((address_space(3)))
typedef unsigned short bf16_t;
typedef short bf16x8 __attribute__((ext_vector_type(8)));
typedef float f32x4 __attribute__((ext_vector_type(4)));
typedef unsigned u32x4 __attribute__((ext_vector_type(4)));
constexpr int BM = 256, BK = 64, HALF = 128, HTB = HALF * BK * 2  , STAGE_BYTES = 8 * HTB, NXCD = 8, WGM = 8;

__host__ __device__ __forceinline__ int lds_byte(int r, int c) { const int st = (r >> 4) * 2 + (c >> 5), rr = r & 15, cc = c & 31, ob = rr * 64 + cc * 2; return st * 1024 + (ob ^ (((ob >> 9) & 1) << 5)); }
__host__ __device__ __forceinline__ void stage_rc(int b, int& R, int& C) { const int st = b / 1024, sb = b % 1024, swz = sb ^ (((sb >> 9) & 1) << 5); R = (st >> 1) * 16 + swz / 64; C = (st & 1) * 32 + (swz % 64) / 2; }
__host__ __device__ __forceinline__ int perm32(int rho) { const int n = rho >> 4, i = rho & 15; return 8 * (i >> 2) + 4 * n + (i & 3); }

struct Unit { int pm, pn; };
struct Gemm { const bf16_t* A; const bf16_t* Bt; int M, N, K; };

struct StaticOrder {
    int nM, nN, nwg, G, c;
    __host__ __device__ void init(int M, int N, int G_, int c_) { nM = M / BM; nN = N / BM; nwg = nM * nN; G = G_; c = c_; }
    __host__ __device__ bool next(int i, Unit& u) const {
        const long L = (long)i * G + c; if (L >= nwg) return false;
        int wgid = (int)L; { const int q = nwg / NXCD, r = nwg % NXCD, xcd = wgid % NXCD, off = wgid / NXCD; wgid = (xcd < r ? xcd * (q + 1) : r * (q + 1) + (xcd - r) * q) + off; }
        const int nig = WGM * nN, gid = wgid / nig, fm = gid * WGM, gsz = (nM - fm) < WGM ? (nM - fm) : WGM;
        u.pm = fm + ((wgid % nig) % gsz); u.pn = (wgid % nig) / gsz; return true;
    }
    __device__ __forceinline__ void a_ready(const Unit&) const {}
    __device__ __forceinline__ void done(const Unit&) const {}
};

typedef float2 rope_t;
DI void rope8(float (&v)[8], const rope_t* cs, int fq, float sc) {
    const f32x4 c0 = *(const f32x4*)(cs), c1 = *(const f32x4*)(cs + 2), c2 = *(const f32x4*)(cs + 4), c3 = *(const f32x4*)(cs + 6);
    const float cc[8] = {c0[0], c0[2], c1[0], c1[2], c2[0], c2[2], c3[0], c3[2]}, ss[8] = {c0[1], c0[3], c1[1], c1[3], c2[1], c2[3], c3[1], c3[3]};
#pragma unroll
    for (int j = 0; j < 8; ++j) { auto rr = __builtin_amdgcn_permlane32_swap(__float_as_uint(v[j]), __float_as_uint(v[j]), false, false);
        const float p = __uint_as_float(fq < 2 ? rr[1] : rr[0]); const float sp = fq < 2 ? -p : p; v[j] = (v[j] * cc[j] + sp * ss[j]) * sc; }
}
DI void store8(bf16_t* p, const float (&v)[8]) { u32x4 w; w.x = cvtpk(v[0], v[1]); w.y = cvtpk(v[2], v[3]); w.z = cvtpk(v[4], v[5]); w.w = cvtpk(v[6], v[7]); *(u32x4*)p = w; }
DI float fq_sum(float s) {
    auto a = __builtin_amdgcn_permlane16_swap(__float_as_uint(s), __float_as_uint(s), false, false); s = __uint_as_float(a[0]) + __uint_as_float(a[1]);
    auto b = __builtin_amdgcn_permlane32_swap(__float_as_uint(s), __float_as_uint(s), false, false); return __uint_as_float(b[0]) + __uint_as_float(b[1]);
}
DI float silu(float x) { return x * __builtin_amdgcn_rcpf(1.f + __expf(-x)); }

struct EpiIn {
    static constexpr bool PERM = true, AFTER_DRAIN = false;
    const float* rs; bf16_t* QK; bf16_t* VT; bf16_t* G; const rope_t* rope; const float* gqn; const float* gkn;
    DI void operator()(const f32x4 (&acc)[2][2][4][2], const Unit& u, int wr, int wc, int fr, int fq) const {
        const int g64 = u.pn * 4 + wc;
#pragma unroll
        for (int ai = 0; ai < 2; ++ai)
#pragma unroll
            for (int m = 0; m < 4; ++m) {
                const int row = u.pm * BM + ai * HALF + wr * 64 + m * 16 + fr, b = row >> 12, t = row & 4095;
                const float rsv = rs[row];
                float v[2][8];
#pragma unroll
                for (int bj = 0; bj < 2; ++bj)
#pragma unroll
                    for (int n = 0; n < 2; ++n)
#pragma unroll
                        for (int i = 0; i < 4; ++i) v[bj][4 * n + i] = acc[ai][bj][m][n][i] * rsv;
                if (g64 < 12) {
                    const float sc = g64 < 6 ? SC_D : 1.f;
                    const rope_t* cs = rope + t * 16 + 8 * (fq & 1);
                    bf16_t* dst = QK + ((size_t)(b * 24 + g64) * 4096 + t) * 64 + 8 * fq;
#pragma unroll
                    for (int bj = 0; bj < 2; ++bj) { rope8(v[bj], cs, fq, sc); store8(dst + 32 * bj, v[bj]); }
                } else if (g64 < 18 || (g64 >= 32 && g64 < 34)) {
                    const int hv = g64 < 18 ? g64 - 12 : g64 - 32 + 6;
                    const bool odd = fr & 1;
                    bf16_t* dst = VT + ((size_t)(b * 8 + hv) * 64 + 8 * fq) * 4096 + vpos(t & ~1);
#pragma unroll
                    for (int bj = 0; bj < 2; ++bj)
#pragma unroll
                        for (int j2 = 0; j2 < 4; ++j2) {
                            const float mine = odd ? v[bj][2 * j2 + 1] : v[bj][2 * j2], send = odd ? v[bj][2 * j2] : v[bj][2 * j2 + 1];
                            const float got = __shfl_xor(send, 1);
                            const unsigned w = odd ? cvtpk(got, mine) : cvtpk(mine, got);
                            *(unsigned*)(dst + (size_t)(32 * bj + 2 * j2 + (odd ? 1 : 0)) * 4096) = w; }
                } else if (g64 < 24 || (g64 >= 34 && g64 < 40) || g64 >= 44) {
                    const int col = g64 < 24 ? (g64 - 18) * 64 : (g64 < 40 ? 384 + (g64 - 34) * 64 : 768 + (g64 - 44) * 64);
                    bf16_t* dst = G + (size_t)row * 1024 + col + 8 * fq;
#pragma unroll
                    for (int bj = 0; bj < 2; ++bj) {
#pragma unroll
                        for (int j = 0; j < 8; ++j) v[bj][j] = silu(v[bj][j]);
                        store8(dst + 32 * bj, v[bj]); }
                } else if (g64 < 32) {
                    float ss = 0.f;
#pragma unroll
                    for (int bj = 0; bj < 2; ++bj)
#pragma unroll
                        for (int j = 0; j < 8; ++j) ss += v[bj][j] * v[bj][j];
                    ss = fq_sum(ss);
                    const float r = rsqrtf(ss * (1.f / 64.f) + NORM_EPS);
                    const bool isq = g64 < 30; const float* gw = (isq ? gqn : gkn) + 8 * fq;
                    const int slot = isq ? 12 + (g64 - 24) : 18 + (g64 - 30);
                    bf16_t* dst = QK + ((size_t)(b * 24 + slot) * 4096 + t) * 64 + 8 * fq;
#pragma unroll
                    for (int bj = 0; bj < 2; ++bj) {
#pragma unroll
                        for (int j = 0; j < 8; ++j) v[bj][j] *= r * gw[32 * bj + j];
                        const int pos = bj == 0 ? (t >> 6) : (t & 63);
                        rope8(v[bj], rope + pos * 16 + 8 * (fq & 1), fq, isq ? SC_G : 1.f);
                        store8(dst + 32 * bj, v[bj]); }
                } else {
                    bf16_t* dst = QK + ((size_t)(b * 24 + 20 + (g64 - 40)) * 4096 + t) * 64 + 8 * fq;
#pragma unroll
                    for (int bj = 0; bj < 2; ++bj) {
#pragma unroll
                        for (int j = 0; j < 8; ++j) v[bj][j] *= SC_G;
                        store8(dst + 32 * bj, v[bj]); }
                }
                if (m == 3) asm volatile("" ::: "memory");
            }
    }
};

struct EpiMemKV {
    static constexpr bool PERM = true, AFTER_DRAIN = false;
    const float* rs; bf16_t* KM; bf16_t* VM;
    DI void operator()(const f32x4 (&acc)[2][2][4][2], const Unit& u, int wr, int wc, int fr, int fq) const {
        const int l = u.pn >> 1, isv = u.pn & 1;
#pragma unroll
        for (int ai = 0; ai < 2; ++ai)
#pragma unroll
            for (int m = 0; m < 4; ++m) {
                const int row = u.pm * BM + ai * HALF + wr * 64 + m * 16 + fr, b = row >> 8, t = row & 255;
                const float rsv = rs[row];
                float v[2][8];
#pragma unroll
                for (int bj = 0; bj < 2; ++bj)
#pragma unroll
                    for (int n = 0; n < 2; ++n)
#pragma unroll
                        for (int i = 0; i < 4; ++i) v[bj][4 * n + i] = acc[ai][bj][m][n][i] * rsv;
                const size_t hb = (size_t)((l * 4 + b) * 4 + wc);
                if (!isv) { bf16_t* dst = KM + (hb * 256 + t) * 64 + 8 * fq;
#pragma unroll
                    for (int bj = 0; bj < 2; ++bj) store8(dst + 32 * bj, v[bj]);
                } else { bf16_t* dst = VM + (hb * 64 + 8 * fq) * 256 + vpos(t);
#pragma unroll
                    for (int bj = 0; bj < 2; ++bj)
#pragma unroll
                        for (int j = 0; j < 8; ++j) dst[(size_t)(32 * bj + j) * 256] = (bf16_t)(cvtpk(v[bj][j], 0.f) & 0xffffu); }
                asm volatile("" ::: "memory");
            }
    }
};

struct EpiOut {
    static constexpr bool PERM = true, AFTER_DRAIN = false;
    bf16_t* Y; float* ssq;
    DI void operator()(const f32x4 (&acc)[2][2][4][2], const Unit& u, int wr, int wc, int fr, int fq) const {
#pragma unroll
        for (int ai = 0; ai < 2; ++ai)
#pragma unroll
            for (int m = 0; m < 4; ++m) {
                const int row = u.pm * BM + ai * HALF + wr * 64 + m * 16 + fr;
                float v[2][8]; float ss = 0.f;
#pragma unroll
                for (int bj = 0; bj < 2; ++bj)
#pragma unroll
                    for (int n = 0; n < 2; ++n)
#pragma unroll
                        for (int i = 0; i < 4; ++i) { const float x = acc[ai][bj][m][n][i]; v[bj][4 * n + i] = x; ss += x * x; }
                ss = fq_sum(ss);
                if (fq == 0) ssq[(size_t)row * 16 + u.pn * 4 + wc] = ss;
                bf16_t* dst = Y + (size_t)row * 1024 + u.pn * BM + wc * 32 + 8 * fq;
#pragma unroll
                for (int bj = 0; bj < 2; ++bj) store8(dst + bj * HALF, v[bj]);
                asm volatile("" ::: "memory");
            }
    }
};

template <class Epi, class Sched, bool ALIGN_EPI = false, bool SP2 = false>
__device__ __forceinline__ void gemm_phase(PG8_LAS unsigned char* lds, const Gemm g, const Sched& S, const Epi& E, int wave_s) {
    const int tid_ = (wave_s << 6) | lane_now();
    const int tid = tid_, wid = __builtin_amdgcn_readfirstlane(tid >> 6), lane = tid & 63, wr = wid >> 2, wc = wid & 3, fr = lane & 15, fq = lane >> 4;
    const int K = g.K, nt = K / BK;
    unsigned voffA[2], voffB[2];
#pragma unroll
    for (int i = 0; i < 2; ++i) { int R, C; stage_rc(tid * 16 + i * 8192, R, C); const int Rb = Epi::PERM ? ((R & ~31) + perm32(R & 31)) : R;
        voffA[i] = (unsigned)(R * K + C) * 2u; voffB[i] = (unsigned)(Rb * K + C) * 2u; }
    const size_t kstep = (size_t)(BK * 2);
    const size_t hstep = (size_t)HALF * K * 2;
    const size_t tstep = 2 * hstep;
    const unsigned ldsw = (unsigned)wid * 1024u;
    const int aoff = lds_byte(wr * 64 + fr, fq * 8), boff = lds_byte(wc * 32 + fr, fq * 8);
#define PG8_SA(b, h) (((b) * 2 + (h)) * HTB)
#define PG8_SB(b, h) ((4 + (b) * 2 + (h)) * HTB)
#define PG8_STAGE(bufoff, gbase, voff) do { _Pragma("unroll") for (int _i = 0; _i < 2; ++_i) \
        __builtin_amdgcn_global_load_lds((const unsigned*)((const char*)(gbase) + (voff)[_i]), (PG8_LAS unsigned*)(lds + (bufoff) + ldsw + _i * 8192), 16, 0, 0); } while (0)
#define PG8_LDA(dst, b, h) do { _Pragma("unroll") for (int m = 0; m < 4; ++m) _Pragma("unroll") for (int k = 0; k < 2; ++k) dst[m][k] = *(const PG8_LAS bf16x8*)(lds + PG8_SA(b, h) + aoff + m * 2048 + k * 1024); } while (0)
#define PG8_LDB(dst, b, h) do { _Pragma("unroll") for (int n = 0; n < 2; ++n) _Pragma("unroll") for (int k = 0; k < 2; ++k) dst[n][k] = *(const PG8_LAS bf16x8*)(lds + PG8_SB(b, h) + boff + n * 2048 + k * 1024); } while (0)
#define PG8_MMA(ai, bj, At, Bt) do { __builtin_amdgcn_s_setprio(1); _Pragma("unroll") for (int m = 0; m < 4; ++m) _Pragma("unroll") for (int n = 0; n < 2; ++n) _Pragma("unroll") for (int k = 0; k < 2; ++k) \
        acc[ai][bj][m][n] = __builtin_amdgcn_mfma_f32_16x16x32_bf16(Bt[n][k], At[m][k], acc[ai][bj][m][n], 0, 0, 0); __builtin_amdgcn_s_setprio(0); } while (0)
#define PG8_WAIT_V(n) asm volatile("s_waitcnt vmcnt(" #n ")" ::: "memory")
#define PG8_WAIT_L(n) asm volatile("s_waitcnt lgkmcnt(" #n ")" ::: "memory")
#define PG8_BAR __builtin_amdgcn_s_barrier()
#define PG8_SCHED __builtin_amdgcn_sched_barrier(0)
    Unit cur, nxt; int ui = 0;
    if (!S.next(0, cur)) return;
    f32x4 acc[2][2][4][2];
#pragma unroll
    for (int a = 0; a < 2; ++a)
#pragma unroll
        for (int b = 0; b < 2; ++b)
#pragma unroll
            for (int m = 0; m < 4; ++m)
#pragma unroll
                for (int n = 0; n < 2; ++n) acc[a][b][m][n] = (f32x4){0.f, 0.f, 0.f, 0.f};
    bf16x8 At[4][2], B0[2][2], B1[2][2];
    const char* cA = (const char*)g.A + (size_t)cur.pm * tstep; const char* cB = (const char*)g.Bt + (size_t)cur.pn * tstep;
    S.a_ready(cur);
    if constexpr (SP2) {
        PG8_STAGE(PG8_SB(0, 0), cB, voffB); PG8_STAGE(PG8_SB(0, 1), cB + hstep, voffB); PG8_STAGE(PG8_SA(0, 0), cA, voffA); PG8_STAGE(PG8_SA(0, 1), cA + hstep, voffA);
        if (wr == 1) PG8_BAR;
        PG8_WAIT_V(2); PG8_BAR;
        PG8_STAGE(PG8_SB(1, 0), cB + kstep, voffB); PG8_STAGE(PG8_SA(1, 0), cA + kstep, voffA); PG8_STAGE(PG8_SB(1, 1), cB + hstep + kstep, voffB);
        PG8_WAIT_V(6); PG8_BAR;
    } else {
        PG8_STAGE(PG8_SB(0, 0), cB, voffB); PG8_STAGE(PG8_SA(0, 0), cA, voffA); PG8_STAGE(PG8_SB(0, 1), cB + hstep, voffB); PG8_STAGE(PG8_SA(0, 1), cA + hstep, voffA);
        if (wr == 1) PG8_BAR;
        PG8_WAIT_V(4); PG8_BAR;
        PG8_STAGE(PG8_SB(1, 0), cB + kstep, voffB); PG8_STAGE(PG8_SA(1, 0), cA + kstep, voffA); PG8_STAGE(PG8_SB(1, 1), cB + hstep + kstep, voffB);
        PG8_WAIT_V(6); PG8_BAR;
    }
    for (;;) {
        const bool has_next = S.next(ui + 1, nxt);
        const char* nA = has_next ? (const char*)g.A + (size_t)nxt.pm * tstep : cA; const char* nB = has_next ? (const char*)g.Bt + (size_t)nxt.pn * tstep : cB;
        for (int t = 0; t < nt; t += 2) {
            const bool last = (t == nt - 2);
            const char* a1 = cA + (size_t)(t + 1) * kstep;
            const char* a2 = last ? nA : cA + (size_t)(t + 2) * kstep; const char* b2 = last ? nB : cB + (size_t)(t + 2) * kstep;
            const char* a3 = a2 + kstep; const char* b3 = b2 + kstep;
            if (last && has_next) S.a_ready(nxt);
            if constexpr (SP2) {
            PG8_LDB(B0, 0, 0); PG8_LDB(B1, 0, 1); PG8_SCHED; PG8_LDA(At, 0, 0); PG8_STAGE(PG8_SA(1, 1), a1 + hstep, voffA);
            PG8_WAIT_V(8); PG8_WAIT_L(0); PG8_BAR; PG8_MMA(0, 0, At, B0); PG8_MMA(0, 1, At, B1); PG8_BAR; PG8_SCHED;
            PG8_LDA(At, 0, 1); PG8_STAGE(PG8_SB(0, 0), b2, voffB); PG8_STAGE(PG8_SB(0, 1), b2 + hstep, voffB); PG8_STAGE(PG8_SA(0, 0), a2, voffA);
            PG8_WAIT_V(8); PG8_WAIT_L(0); PG8_BAR; PG8_MMA(1, 0, At, B0); PG8_MMA(1, 1, At, B1); PG8_BAR; PG8_SCHED;
            PG8_LDB(B0, 1, 0); PG8_LDB(B1, 1, 1); PG8_SCHED; PG8_LDA(At, 1, 0); PG8_STAGE(PG8_SA(0, 1), a2 + hstep, voffA);
            PG8_WAIT_V(8); PG8_WAIT_L(0); PG8_BAR; PG8_MMA(0, 0, At, B0); PG8_MMA(0, 1, At, B1); PG8_BAR; PG8_SCHED;
            PG8_LDA(At, 1, 1); PG8_STAGE(PG8_SB(1, 0), b3, voffB); PG8_STAGE(PG8_SB(1, 1), b3 + hstep, voffB); PG8_STAGE(PG8_SA(1, 0), a3, voffA);
            PG8_WAIT_V(8); PG8_WAIT_L(0); PG8_BAR; PG8_MMA(1, 0, At, B0); PG8_MMA(1, 1, At, B1); PG8_BAR; PG8_SCHED;
            } else {
            PG8_LDB(B0, 0, 0); PG8_SCHED; PG8_LDA(At, 0, 0); PG8_STAGE(PG8_SA(1, 1), a1 + hstep, voffA);
            PG8_WAIT_L(8); PG8_BAR; PG8_WAIT_L(0); PG8_MMA(0, 0, At, B0); PG8_BAR; PG8_SCHED;
            PG8_LDB(B1, 0, 1); PG8_STAGE(PG8_SB(0, 0), b2, voffB);
            PG8_BAR; PG8_WAIT_L(0); PG8_MMA(0, 1, At, B1); PG8_BAR;
            PG8_LDA(At, 0, 1); PG8_STAGE(PG8_SA(0, 0), a2, voffA);
            PG8_BAR; PG8_WAIT_L(0); PG8_MMA(1, 0, At, B0); PG8_BAR; PG8_SCHED;
            PG8_STAGE(PG8_SB(0, 1), b2 + hstep, voffB);
            PG8_WAIT_V(6); PG8_BAR; PG8_MMA(1, 1, At, B1); PG8_BAR;
            PG8_LDB(B0, 1, 0); PG8_SCHED; PG8_LDA(At, 1, 0); PG8_STAGE(PG8_SA(0, 1), a2 + hstep, voffA);
            PG8_WAIT_L(8); PG8_BAR; PG8_WAIT_L(0); PG8_MMA(0, 0, At, B0); PG8_BAR; PG8_SCHED;
            PG8_LDB(B1, 1, 1); PG8_STAGE(PG8_SB(1, 0), b3, voffB);
            PG8_BAR; PG8_WAIT_L(0); PG8_MMA(0, 1, At, B1); PG8_BAR;
            PG8_LDA(At, 1, 1); PG8_STAGE(PG8_SA(1, 0), a3, voffA);
            PG8_BAR; PG8_WAIT_L(0); PG8_MMA(1, 0, At, B0); PG8_BAR; PG8_SCHED;
            PG8_STAGE(PG8_SB(1, 1), b3 + hstep, voffB);
            PG8_WAIT_V(6); PG8_BAR; PG8_MMA(1, 1, At, B1); PG8_BAR;
            }
        }
        if constexpr (ALIGN_EPI) { if (wr == 0) PG8_BAR; }
        if constexpr (!Epi::AFTER_DRAIN) { E(acc, cur, wr, wc, fr, fq); S.done(cur); }
        if (!has_next) break;
#pragma unroll
        for (int a = 0; a < 2; ++a)
#pragma unroll
            for (int b = 0; b < 2; ++b)
#pragma unroll
                for (int m = 0; m < 4; ++m)
#pragma unroll
                    for (int n = 0; n < 2; ++n) acc[a][b][m][n] = (f32x4){0.f, 0.f, 0.f, 0.f};
        cur = nxt; cA = nA; cB = nB; ++ui;
        if constexpr (ALIGN_EPI) { if (wr == 1) PG8_BAR; }
    }
    PG8_WAIT_V(0);
    if constexpr (!ALIGN_EPI) { if (wr == 0) PG8_BAR; }
    PG8_BAR;
    if constexpr (Epi::AFTER_DRAIN) { E.fused(acc, cur, wr, wc, fr, fq, lds, wid, lane); S.done(cur); }
#undef PG8_SA
#undef PG8_SB
#undef PG8_STAGE
#undef PG8_LDA
#undef PG8_LDB
#undef PG8_MMA
#undef PG8_WAIT_V
#undef PG8_WAIT_L
#undef PG8_BAR
#undef PG8_SCHED
}
}
#undef LAS
namespace att {
#define LAS __attribute__((address_space(3)))
typedef unsigned short bf16_t;
typedef short bf16x8 __attribute__((ext_vector_type(8)));
typedef float f32x16 __attribute__((ext_vector_type(16)));
typedef unsigned u32x4 __attribute__((ext_vector_type(4)));
typedef unsigned u32x2 __attribute__((ext_vector_type(2)));
typedef float f32x4 __attribute__((ext_vector_type(4)));
typedef float f32x4s __attribute__((ext_vector_type(4)));
constexpr int ROWB = 144, SLOT = 64 * ROWB;
constexpr int KOFF = 0, VOFF = 3 * SLOT;
constexpr int ATT_LDS = 5 * SLOT;
constexpr float THR = 8.f;
#ifndef PROBE_FORCE_REDO
#define PROBE_FORCE_REDO 0
#endif
#ifndef PROBE_NOMAX
#define PROBE_NOMAX 0
#endif
#define MFMA32(a, b, c) __builtin_amdgcn_mfma_f32_32x32x16_bf16((a), (b), (c), 0, 0, 0)
DI float hmax(float m) { auto rr = __builtin_amdgcn_permlane32_swap(__float_as_uint(m), __float_as_uint(m), false, false); return __builtin_fmaxf(__uint_as_float(rr[0]), __uint_as_float(rr[1])); }
DI float hsum(float m) { auto rr = __builtin_amdgcn_permlane32_swap(__float_as_uint(m), __float_as_uint(m), false, false); return __uint_as_float(rr[0]) + __uint_as_float(rr[1]); }
DI f32x16 splat16(float v) { return (f32x16){v, v, v, v, v, v, v, v, v, v, v, v, v, v, v, v}; }
DI float mx3(float a, float b, float c) { return __builtin_fmaxf(__builtin_fmaxf(a, b), c); }
DI float rowmax(const f32x16& p0, const f32x16& p1) {
    const float NEG = -3.0e38f;
    float a = mx3(NEG, p0[0], p0[1]), b = mx3(NEG, p1[0], p1[1]);
#pragma unroll
    for (int r = 2; r < 16; r += 2) { a = mx3(a, p0[r], p0[r + 1]); b = mx3(b, p1[r], p1[r + 1]); }
    a = __builtin_fmaxf(a, b);
    auto rr = __builtin_amdgcn_permlane32_swap(__float_as_uint(a), __float_as_uint(a), false, false);
    return mx3(NEG, __uint_as_float(rr[0]), __uint_as_float(rr[1]));
}
DI void reference(f32x16& p0, f32x16& p1, float& mref, float& l, f32x16& negm, f32x16& o0, f32x16& o1, bool first, f32x16* ls = nullptr, f32x4s* l4 = nullptr) {
#if PROBE_NOMAX
    if (!first) return;
#endif
    const float mx = rowmax(p0, p1);
    if (first) {
        mref = mx;
#pragma unroll
        for (int r = 0; r < 16; ++r) { p0[r] -= mx; p1[r] -= mx; }
        negm = splat16(-mx);
    } else if (__any(mx > THR)) {
        const float dl = __builtin_fmaxf(mx, 0.f);
        mref += dl;
        const float al = __builtin_amdgcn_exp2f(-dl);
        l *= al;
#pragma unroll
        for (int r = 0; r < 16; ++r) { p0[r] -= dl; p1[r] -= dl; o0[r] *= al; o1[r] *= al; }
        if (ls) { (*ls)[0] *= al; }
        if (l4) { (*l4)[0] *= al; }
        negm = splat16(-mref);
    }
}
template <int DS0, int NDS>
DI void qk_issue(f32x16& n0, f32x16& n1, const LAS unsigned char* kb, const bf16x8 (&qf)[4], const f32x16& c) {
#pragma unroll
    for (int ds = DS0; ds < DS0 + NDS; ++ds) {
        const bf16x8 a0 = *(const LAS bf16x8*)(kb + ds * 32), a1 = *(const LAS bf16x8*)(kb + 32 * ROWB + ds * 32);
        if (ds == DS0) { n0 = MFMA32(a0, qf[ds], c); n1 = MFMA32(a1, qf[ds], c); }
        else { n0 = MFMA32(a0, qf[ds], n0); n1 = MFMA32(a1, qf[ds], n1); } }
}
template <bool NOEXP = false, bool SUM = true>
DI void exp_pack(f32x16& p0, f32x16& p1, float& l, bf16x8 (&pb)[4]) {
#pragma unroll
    for (int r = 0; r < 16; ++r) { if (NOEXP) { p0[r] = p0[r] * 0.001f; p1[r] = p1[r] * 0.001f; } else { p0[r] = __builtin_amdgcn_exp2f(p0[r]); p1[r] = __builtin_amdgcn_exp2f(p1[r]); } }
    if (SUM) {
    float s0 = 0.f, s1 = 0.f;
#pragma unroll
    for (int r = 0; r < 16; r += 2) { s0 += p0[r] + p1[r]; s1 += p0[r + 1] + p1[r + 1]; }
    l += s0 + s1; }
    u32x4 w;
    w.x = cvtpk(p0[0], p0[1]); w.y = cvtpk(p0[2], p0[3]); w.z = cvtpk(p0[4], p0[5]); w.w = cvtpk(p0[6], p0[7]); pb[0] = __builtin_bit_cast(bf16x8, w);
    w.x = cvtpk(p0[8], p0[9]); w.y = cvtpk(p0[10], p0[11]); w.z = cvtpk(p0[12], p0[13]); w.w = cvtpk(p0[14], p0[15]); pb[1] = __builtin_bit_cast(bf16x8, w);
    w.x = cvtpk(p1[0], p1[1]); w.y = cvtpk(p1[2], p1[3]); w.z = cvtpk(p1[4], p1[5]); w.w = cvtpk(p1[6], p1[7]); pb[2] = __builtin_bit_cast(bf16x8, w);
    w.x = cvtpk(p1[8], p1[9]); w.y = cvtpk(p1[10], p1[11]); w.z = cvtpk(p1[12], p1[13]); w.w = cvtpk(p1[14], p1[15]); pb[3] = __builtin_bit_cast(bf16x8, w);
}
DI void pv_issue(f32x16& o0, f32x16& o1, const LAS unsigned char* vb, const bf16x8 (&pb)[4]) {
#pragma unroll
    for (int s = 0; s < 4; ++s) {
        const bf16x8 v0 = *(const LAS bf16x8*)(vb + s * 32), v1 = *(const LAS bf16x8*)(vb + 32 * ROWB + s * 32);
        o0 = MFMA32(v0, pb[s], o0); o1 = MFMA32(v1, pb[s], o1); }
}

template <int DS0, int NDS>
DI void kload(bf16x8 (&kf)[2 * NDS], const LAS unsigned char* kb) {
#pragma unroll
    for (int i = 0; i < NDS; ++i) { kf[2 * i] = *(const LAS bf16x8*)(kb + (DS0 + i) * 32); kf[2 * i + 1] = *(const LAS bf16x8*)(kb + 32 * ROWB + (DS0 + i) * 32); }
}
template <int DS0, int NDS>
DI void qk_mma(f32x16& n0, f32x16& n1, const bf16x8 (&kf)[2 * NDS], const bf16x8 (&qf)[4], const f32x16& c) {
#pragma unroll
    for (int i = 0; i < NDS; ++i) {
        if (i == 0) { n0 = MFMA32(kf[0], qf[DS0], c); n1 = MFMA32(kf[1], qf[DS0], c); }
        else { n0 = MFMA32(kf[2 * i], qf[DS0 + i], n0); n1 = MFMA32(kf[2 * i + 1], qf[DS0 + i], n1); } }
}
DI void vload(bf16x8 (&vf)[8], const LAS unsigned char* vb) {
#pragma unroll
    for (int s = 0; s < 4; ++s) { vf[2 * s] = *(const LAS bf16x8*)(vb + s * 32); vf[2 * s + 1] = *(const LAS bf16x8*)(vb + 32 * ROWB + s * 32); }
}
DI void pv_mma(f32x16& o0, f32x16& o1, const bf16x8 (&vf)[8], const bf16x8 (&pb)[4]) {
#pragma unroll
    for (int s = 0; s < 4; ++s) { o0 = MFMA32(vf[2 * s], pb[s], o0); o1 = MFMA32(vf[2 * s + 1], pb[s], o1); }
}
DI void pv_mma_sum(f32x16& o0, f32x16& o1, f32x16& ls, const bf16x8 (&vf)[8], const bf16x8 (&pb)[4]) {
    const bf16x8 ones = {0x3f80, 0x3f80, 0x3f80, 0x3f80, 0x3f80, 0x3f80, 0x3f80, 0x3f80};
#pragma unroll
    for (int s = 0; s < 4; ++s) { o0 = MFMA32(vf[2 * s], pb[s], o0); o1 = MFMA32(vf[2 * s + 1], pb[s], o1); ls = MFMA32(ones, pb[s], ls); }
}
#define SBAR() __builtin_amdgcn_sched_barrier(0)

DI void e8(f32x16& p, int base_is_8, bf16x8& pb) {
    u32x4 w;
    if (!base_is_8) { _Pragma("unroll") for (int r = 0; r < 8; ++r) p[r] = __builtin_amdgcn_exp2f(p[r]);
        w.x = cvtpk(p[0], p[1]); w.y = cvtpk(p[2], p[3]); w.z = cvtpk(p[4], p[5]); w.w = cvtpk(p[6], p[7]); }
    else { _Pragma("unroll") for (int r = 8; r < 16; ++r) p[r] = __builtin_amdgcn_exp2f(p[r]);
        w.x = cvtpk(p[8], p[9]); w.y = cvtpk(p[10], p[11]); w.z = cvtpk(p[12], p[13]); w.w = cvtpk(p[14], p[15]); }
    pb = __builtin_bit_cast(bf16x8, w);
}
DI void half_step_std(f32x16& c0, f32x16& c1, f32x16& n0, f32x16& n1, const bf16x8 (&kf)[8], const bf16x8 (&vf)[8], const bf16x8 (&qf)[4], const f32x16& ng,
                      f32x16& o0, f32x16& o1, f32x16& ls) {
    const bf16x8 ones = {0x3f80, 0x3f80, 0x3f80, 0x3f80, 0x3f80, 0x3f80, 0x3f80, 0x3f80};
    bf16x8 pb0, pb1, pb2, pb3;
    SBAR();
    e8(c0, 0, pb0);
    n0 = MFMA32(kf[0], qf[0], ng); n1 = MFMA32(kf[1], qf[0], ng);
    SBAR();
    e8(c0, 1, pb1);
    n0 = MFMA32(kf[2], qf[1], n0); n1 = MFMA32(kf[3], qf[1], n1);
    o0 = MFMA32(vf[0], pb0, o0); o1 = MFMA32(vf[1], pb0, o1); ls = MFMA32(ones, pb0, ls);
    SBAR();
    e8(c1, 0, pb2);
    n0 = MFMA32(kf[4], qf[2], n0); n1 = MFMA32(kf[5], qf[2], n1);
    o0 = MFMA32(vf[2], pb1, o0); o1 = MFMA32(vf[3], pb1, o1); ls = MFMA32(ones, pb1, ls);
    SBAR();
    e8(c1, 1, pb3);
    n0 = MFMA32(kf[6], qf[3], n0); n1 = MFMA32(kf[7], qf[3], n1);
    o0 = MFMA32(vf[4], pb2, o0); o1 = MFMA32(vf[5], pb2, o1); ls = MFMA32(ones, pb2, ls);
    SBAR();
    o0 = MFMA32(vf[6], pb3, o0); o1 = MFMA32(vf[7], pb3, o1); ls = MFMA32(ones, pb3, ls);
}

DI bf16x8 sum_selector(int lane) {
    const int row = lane & 15, g = lane >> 4;
    const bool on = ((row == 0 || row == 8) && (g == 0 || g == 2)) || ((row == 4 || row == 12) && (g == 1 || g == 3));
    const short v = on ? (short)0x3f80 : (short)0;
    return (bf16x8){v, v, v, v, v, v, v, v};
}
#define MFMA16(a, b, c) __builtin_amdgcn_mfma_f32_16x16x32_bf16((a), (b), (c), 0, 0, 0)

DI void pv_mma_sel(f32x16& o0, f32x16& o1, f32x4s& l4, const bf16x8& asel, const bf16x8 (&vf)[8], const bf16x8 (&pb)[4]) {
#pragma unroll
    for (int s = 0; s < 4; ++s) { o0 = MFMA32(vf[2 * s], pb[s], o0); o1 = MFMA32(vf[2 * s + 1], pb[s], o1); l4 = MFMA16(asel, pb[s], l4); }
}

DI void e8s(f32x16& p, int hi8, bf16x8& pb, float& l) {
    u32x4 w; float s;
    if (!hi8) { _Pragma("unroll") for (int r = 0; r < 8; ++r) p[r] = __builtin_amdgcn_exp2f(p[r]);
        s = ((p[0] + p[1]) + (p[2] + p[3])) + ((p[4] + p[5]) + (p[6] + p[7]));
        w.x = cvtpk(p[0], p[1]); w.y = cvtpk(p[2], p[3]); w.z = cvtpk(p[4], p[5]); w.w = cvtpk(p[6], p[7]); }
    else { _Pragma("unroll") for (int r = 8; r < 16; ++r) p[r] = __builtin_amdgcn_exp2f(p[r]);
        s = ((p[8] + p[9]) + (p[10] + p[11])) + ((p[12] + p[13]) + (p[14] + p[15]));
        w.x = cvtpk(p[8], p[9]); w.y = cvtpk(p[10], p[11]); w.z = cvtpk(p[12], p[13]); w.w = cvtpk(p[14], p[15]); }
    l += s; pb = __builtin_bit_cast(bf16x8, w);
}
template <int DS0>
DI void half_step_diff(f32x16& c0, f32x16& c1, f32x16& n0, f32x16& n1, const bf16x8 (&kf)[4], const bf16x8 (&vf)[8], const bf16x8 (&qf)[4], const f32x16& ng,
                       f32x16& o0, f32x16& o1, f32x4s& l4, const bf16x8& asel) {
    bf16x8 pb0, pb1, pb2, pb3;
    SBAR();
    e8(c0, 0, pb0);
    n0 = MFMA32(kf[0], qf[DS0], ng); n1 = MFMA32(kf[1], qf[DS0], ng);
    SBAR();
    e8(c0, 1, pb1);
    n0 = MFMA32(kf[2], qf[DS0 + 1], n0); n1 = MFMA32(kf[3], qf[DS0 + 1], n1);
    o0 = MFMA32(vf[0], pb0, o0); o1 = MFMA32(vf[1], pb0, o1); l4 = MFMA16(asel, pb0, l4);
    SBAR();
    e8(c1, 0, pb2);
    o0 = MFMA32(vf[2], pb1, o0); o1 = MFMA32(vf[3], pb1, o1); l4 = MFMA16(asel, pb1, l4);
    SBAR();
    e8(c1, 1, pb3);
    o0 = MFMA32(vf[4], pb2, o0); o1 = MFMA32(vf[5], pb2, o1); l4 = MFMA16(asel, pb2, l4);
    SBAR();
    o0 = MFMA32(vf[6], pb3, o0); o1 = MFMA32(vf[7], pb3, o1); l4 = MFMA16(asel, pb3, l4);
}

template <bool DIFF, bool NOEXP = false, bool FAST = false>
DI bool attn_unit(LAS unsigned char* lds, const bf16_t* __restrict__ Qp, const bf16_t* __restrict__ Kp, const bf16_t* __restrict__ Vtp, int nk, bf16_t* Gp,
                  const float* lamp, const float* subln, int layer, bool dry, int wave_s) {
    const int tid_ = (wave_s << 6) | lane_now();
    const int tid = tid_, lane = tid & 63, r32 = lane & 31, hi = lane >> 5; const int wid = __builtin_amdgcn_readfirstlane(tid >> 6);
    bf16x8 qf[4];
    { const bf16_t* qrow = Qp + (size_t)(wid * 32 + r32) * 64 + hi * 8;
#pragma unroll
      for (int ds = 0; ds < 4; ++ds) qf[ds] = *(const bf16x8*)(qrow + ds * 16); }
    const int lrow = tid >> 3, lch = tid & 7;
    const bf16_t* kg = Kp + (size_t)lrow * 64 + lch * 8;
    const bf16_t* vg = Vtp + (size_t)lrow * nk + lch * 8;
    const unsigned lw = lrow * ROWB + lch * 16;
    const int NT = nk >> 6;
    u32x4 kreg, vreg;
    { const u32x4 k0 = *(const u32x4*)kg, v0 = *(const u32x4*)vg, k1 = *(const u32x4*)(kg + 4096);
      *(LAS u32x4*)(lds + KOFF + lw) = k0; *(LAS u32x4*)(lds + VOFF + lw) = v0; *(LAS u32x4*)(lds + KOFF + SLOT + lw) = k1; }
    kreg = *(const u32x4*)(kg + (size_t)2 * 4096); vreg = *(const u32x4*)(vg + 64);
    __syncthreads();
    float m1 = 0.f, l1 = 0.f, m2 = 0.f, l2 = 0.f;
    f32x16 oa0, oa1, ob0, ob1, ng1, ng2;
#pragma unroll
    for (int r = 0; r < 16; ++r) { oa0[r] = 0.f; oa1[r] = 0.f; ob0[r] = 0.f; ob1[r] = 0.f; }
    ng1 = splat16(0.f); ng2 = splat16(0.f);
    const unsigned fro = r32 * ROWB + hi * 16;
    f32x16 pa0, pa1, pc0, pc1;
    qk_issue<0, DIFF ? 2 : 4>(pa0, pa1, lds + KOFF + fro, qf, ng1);
    int kc = 0, kn = SLOT, kw = 2 * SLOT;
#ifndef PROBE_VAR
#define PROBE_VAR 0
#endif
#define STAGE(t) do { if (PROBE_VAR == 1 && dry) { const int o_ = kc; kc = kn; kn = kw; kw = o_; break; } *(LAS u32x4*)(lds + KOFF + kw + lw) = kreg; *(LAS u32x4*)(lds + VOFF + (((t) + 1) & 1) * SLOT + lw) = vreg; \
        { const int tk = (t) + 3 < NT ? (t) + 3 : NT - 1, tv = (t) + 2 < NT ? (t) + 2 : NT - 1; \
          kreg = *(const u32x4*)(kg + (size_t)tk * 4096); vreg = *(const u32x4*)(vg + (size_t)tv * 64); } \
        { const int o_ = kc; kc = kn; kn = kw; kw = o_; } \
        __syncthreads(); } while (0)
    if (DIFF) {
        f32x4s l4a = {0.f, 0.f, 0.f, 0.f}, l4b = {0.f, 0.f, 0.f, 0.f};
        const bf16x8 asel = sum_selector(lane);
        for (int t = 0; t < NT; ++t) {
            bf16x8 pb[4], kf[4], vf[8];
            kload<2, 2>(kf, lds + KOFF + kc + fro);
            if (!FAST) reference(pa0, pa1, m1, l1, ng1, oa0, oa1, t == 0, nullptr, &l4a);
            vload(vf, lds + VOFF + (t & 1) * SLOT + fro);
            { const f32x16 c = splat16(FAST ? 0.f : -m2);
              half_step_diff<2>(pa0, pa1, pc0, pc1, kf, vf, qf, c, oa0, oa1, l4a, asel); }
            SBAR();
            kload<0, 2>(kf, lds + KOFF + kn + fro);
            if (!FAST) reference(pc0, pc1, m2, l2, ng2, ob0, ob1, t == 0, nullptr, &l4b);

            { const f32x16 c = splat16(FAST ? 0.f : -m1);
              half_step_diff<0>(pc0, pc1, pa0, pa1, kf, vf, qf, c, ob0, ob1, l4b, asel); }
            STAGE(t);
        }
        l1 = 0.5f * l4a[0]; l2 = 0.5f * l4b[0];
    } else {
        f32x4s l4s = {0.f, 0.f, 0.f, 0.f};
        const bf16x8 asel = sum_selector(lane);
#define HALF_STD(CUR0, CUR1, NXT0, NXT1, t) do { bf16x8 pb[4], kf[8], vf[8]; \
            kload<0, 4>(kf, lds + KOFF + kn + fro); vload(vf, lds + VOFF + ((t) & 1) * SLOT + fro); \
            if (!FAST) reference(CUR0, CUR1, m1, l1, ng1, oa0, oa1, (t) == 0, nullptr, &l4s); \
            qk_mma<0, 4>(NXT0, NXT1, kf, qf, ng1); \
            exp_pack<NOEXP, false>(CUR0, CUR1, l1, pb); \
            pv_mma_sel(oa0, oa1, l4s, asel, vf, pb); \
            STAGE(t); } while (0)
        for (int t = 0; t < NT; t += 2) {
            HALF_STD(pa0, pa1, pc0, pc1, t);
            HALF_STD(pc0, pc1, pa0, pa1, t + 1);
        }
#undef HALF_STD
        l1 = 0.5f * l4s[0];
    }
#undef STAGE
    if (FAST) {
        bool bad = !(l1 < 1.0e30f && l1 > 1.0e-30f);
        if (DIFF) bad = bad || !(l2 < 1.0e30f && l2 > 1.0e-30f);
#if PROBE_FORCE_REDO
        bad = bad || ((wid & 1) == 0 && r32 == 3);
#endif
        LAS unsigned* fl = (LAS unsigned*)(lds + ATT_LDS);
        if (lane == 0) fl[wid] = 0u;
        if (__any(bad) && lane == 0) fl[wid] = 1u;
        __syncthreads();
        unsigned anyb = 0u;
#pragma unroll
        for (int w = 0; w < 8; ++w) anyb |= fl[w];
        if (anyb) return true;
    }
    const float inv1 = 1.f / hsum(l1);
    f32x16 oA[2] = {oa0, oa1};
    LAS unsigned char* stg = lds + 49152 + wid * 8704;
    if (DIFF) {
        const float lam = *lamp, out_scale = 1.f - (0.8f - 0.6f * __expf(-0.3f * (float)layer));
        const float inv2 = lam / hsum(l2);
        float ss = 0.f;
#pragma unroll
        for (int dh = 0; dh < 2; ++dh)
#pragma unroll
            for (int r = 0; r < 16; ++r) { const float x = oA[dh][r] * inv1 - (dh == 0 ? ob0[r] : ob1[r]) * inv2; oA[dh][r] = x; ss += x * x; }
        ss = hsum(ss);
        const float rn = rsqrtf(ss * (1.f / 64.f) + NORM_EPS) * out_scale;
#pragma unroll
        for (int dh = 0; dh < 2; ++dh)
#pragma unroll
            for (int g = 0; g < 4; ++g) {
                const int d0 = 32 * dh + 8 * g + 4 * hi;
                const f32x4 sw = *(const f32x4*)(subln + d0);
                *(LAS f32x4*)(stg + r32 * 272 + d0 * 4) = (f32x4){oA[dh][4 * g] * rn * sw[0], oA[dh][4 * g + 1] * rn * sw[1], oA[dh][4 * g + 2] * rn * sw[2], oA[dh][4 * g + 3] * rn * sw[3]}; }
    } else {
#pragma unroll
        for (int dh = 0; dh < 2; ++dh)
#pragma unroll
            for (int g = 0; g < 4; ++g)
                *(LAS f32x4*)(stg + r32 * 272 + (32 * dh + 8 * g + 4 * hi) * 4) = (f32x4){oA[dh][4 * g] * inv1, oA[dh][4 * g + 1] * inv1, oA[dh][4 * g + 2] * inv1, oA[dh][4 * g + 3] * inv1};
    }
    { bf16_t* gbase = Gp + (size_t)(wid * 32) * 1024;
      u32x4 gg[4];
#pragma unroll
      for (int k = 0; k < 4; ++k) { const int j = lane + 64 * k; gg[k] = *(const u32x4*)(gbase + (size_t)(j >> 3) * 1024 + (j & 7) * 8); }
#pragma unroll
      for (int k = 0; k < 4; ++k) { const int j = lane + 64 * k, row = j >> 3, c8 = j & 7;
          const f32x4 a = *(const LAS f32x4*)(stg + row * 272 + c8 * 32), b = *(const LAS f32x4*)(stg + row * 272 + c8 * 32 + 16);
          u32x4 w; w.x = cvtpk(a[0] * bf_lo(gg[k].x), a[1] * bf_hi(gg[k].x)); w.y = cvtpk(a[2] * bf_lo(gg[k].y), a[3] * bf_hi(gg[k].y));
          w.z = cvtpk(b[0] * bf_lo(gg[k].z), b[1] * bf_hi(gg[k].z)); w.w = cvtpk(b[2] * bf_lo(gg[k].w), b[3] * bf_hi(gg[k].w));
          if (!dry) *(u32x4*)(gbase + (size_t)row * 1024 + c8 * 8) = w; } }
    return false;
}

DI void attn_unit_split(LAS unsigned char* lds, const bf16_t* __restrict__ Qp, const bf16_t* __restrict__ Kp, const bf16_t* __restrict__ Vtp, int nk, bf16_t* Gp, bool dry, int wave_s) {
    const int tid_ = (wave_s << 6) | lane_now();
    const int tid = tid_, lane = tid & 63, r32 = lane & 31, hi = lane >> 5; const int wid = __builtin_amdgcn_readfirstlane(tid >> 6);
    const int grp = wid >> 2, wq = wid & 3;
    bf16x8 qf[4];
    { const bf16_t* qrow = Qp + (size_t)(wq * 32 + r32) * 64 + hi * 8;
#pragma unroll
      for (int ds = 0; ds < 4; ++ds) qf[ds] = *(const bf16x8*)(qrow + ds * 16); }
    const int NT = nk >> 7;
    const int gt = tid & 255, lrow = gt >> 3, lch = gt & 7;
    const bf16_t* kg = Kp + ((size_t)grp * NT * 64 + lrow) * 64 + lch * 8;
    const bf16_t* vg = Vtp + (size_t)lrow * nk + grp * NT * 64 + lch * 8;
    LAS unsigned char* ring = lds + grp * ATT_LDS;
    const unsigned lw = lrow * ROWB + lch * 16;
    u32x4 kreg0, kreg1, vreg0, vreg1;
    { const u32x4 k0 = *(const u32x4*)kg, k0b = *(const u32x4*)(kg + 32 * 64), v0 = *(const u32x4*)vg, v0b = *(const u32x4*)(vg + (size_t)32 * nk);
      const u32x4 k1 = *(const u32x4*)(kg + 4096), k1b = *(const u32x4*)(kg + 4096 + 32 * 64);
      *(LAS u32x4*)(ring + KOFF + lw) = k0; *(LAS u32x4*)(ring + KOFF + 32 * ROWB + lw) = k0b; *(LAS u32x4*)(ring + VOFF + lw) = v0; *(LAS u32x4*)(ring + VOFF + 32 * ROWB + lw) = v0b;
      *(LAS u32x4*)(ring + KOFF + SLOT + lw) = k1; *(LAS u32x4*)(ring + KOFF + SLOT + 32 * ROWB + lw) = k1b; }
    kreg0 = *(const u32x4*)(kg + (size_t)2 * 4096); kreg1 = *(const u32x4*)(kg + (size_t)2 * 4096 + 32 * 64);
    vreg0 = *(const u32x4*)(vg + 64); vreg1 = *(const u32x4*)(vg + (size_t)32 * nk + 64);
    __syncthreads();
    float m1 = 0.f, l1 = 0.f;
    f32x16 oa0, oa1, ng1 = splat16(0.f), ls = splat16(0.f);
#pragma unroll
    for (int r = 0; r < 16; ++r) { oa0[r] = 0.f; oa1[r] = 0.f; }
    const unsigned fro = r32 * ROWB + hi * 16;
    f32x16 pa0, pa1, pc0, pc1;
    { bf16x8 kf[8]; kload<0, 4>(kf, ring + KOFF + fro); qk_mma<0, 4>(pa0, pa1, kf, qf, ng1); }
    int kc = 0, kn = SLOT, kw = 2 * SLOT;
#define STAGE2(t) do { *(LAS u32x4*)(ring + KOFF + kw + lw) = kreg0; *(LAS u32x4*)(ring + KOFF + kw + 32 * ROWB + lw) = kreg1; \
        *(LAS u32x4*)(ring + VOFF + (((t) + 1) & 1) * SLOT + lw) = vreg0; *(LAS u32x4*)(ring + VOFF + (((t) + 1) & 1) * SLOT + 32 * ROWB + lw) = vreg1; \
        { const int tk = (t) + 3 < NT ? (t) + 3 : NT - 1, tv = (t) + 2 < NT ? (t) + 2 : NT - 1; \
          kreg0 = *(const u32x4*)(kg + (size_t)tk * 4096); kreg1 = *(const u32x4*)(kg + (size_t)tk * 4096 + 32 * 64); \
          vreg0 = *(const u32x4*)(vg + (size_t)tv * 64); vreg1 = *(const u32x4*)(vg + (size_t)32 * nk + (size_t)tv * 64); } \
        { const int o_ = kc; kc = kn; kn = kw; kw = o_; } \
        __syncthreads(); } while (0)
#define HALF_SPL(CUR0, CUR1, NXT0, NXT1, t) do { bf16x8 pb[4], kf[8], vf[8]; \
        kload<0, 4>(kf, ring + KOFF + kn + fro); vload(vf, ring + VOFF + ((t) & 1) * SLOT + fro); \
        reference(CUR0, CUR1, m1, l1, ng1, oa0, oa1, (t) == 0, &ls); \
        qk_mma<0, 4>(NXT0, NXT1, kf, qf, ng1); \
        exp_pack<false, false>(CUR0, CUR1, l1, pb); \
        pv_mma_sum(oa0, oa1, ls, vf, pb); \
        STAGE2(t); } while (0)
    for (int t = 0; t < NT; t += 2) {
        HALF_SPL(pa0, pa1, pc0, pc1, t);
        HALF_SPL(pc0, pc1, pa0, pa1, t + 1);
    }
#undef HALF_SPL
#undef STAGE2
    LAS float* mb = (LAS float*)lds + (wq * 64 + lane) * 35;
    if (grp == 1) {
        mb[0] = m1; mb[1] = ls[0];
#pragma unroll
        for (int r = 0; r < 16; ++r) { mb[2 + r] = oa0[r]; mb[18 + r] = oa1[r]; }
    }
    __syncthreads();
    if (grp == 0) {
        const float mB = mb[0], lB = mb[1];
        const float mm = __builtin_fmaxf(m1, mB), fa = __builtin_amdgcn_exp2f(m1 - mm), fb = __builtin_amdgcn_exp2f(mB - mm);
        const float inv = 1.f / (ls[0] * fa + lB * fb);
        const float ia = fa * inv, ib = fb * inv;
#pragma unroll
        for (int r = 0; r < 16; ++r) { oa0[r] = oa0[r] * ia + mb[2 + r] * ib; oa1[r] = oa1[r] * ia + mb[18 + r] * ib; }
        f32x16 oA[2] = {oa0, oa1};
        bf16_t* grow = Gp + (size_t)(wq * 32 + r32) * 1024 + 4 * hi;
#pragma unroll
        for (int dh = 0; dh < 2; ++dh)
#pragma unroll
            for (int g = 0; g < 4; ++g) {
                const u32x2 gg = *(const u32x2*)(grow + 32 * dh + 8 * g);
                const float a = oA[dh][4 * g] * bf_lo(gg.x), b = oA[dh][4 * g + 1] * bf_hi(gg.x);
                const float c = oA[dh][4 * g + 2] * bf_lo(gg.y), d = oA[dh][4 * g + 3] * bf_hi(gg.y);
                u32x2 w; w.x = cvtpk(a, b); w.y = cvtpk(c, d); if (!dry) *(u32x2*)(grow + 32 * dh + 8 * g) = w; }
    }
    __syncthreads();
}
}
#undef LAS
#define LAS __attribute__((address_space(3)))
typedef unsigned short bf16_t;
typedef float f32x4 __attribute__((ext_vector_type(4)));
typedef unsigned u32x4 __attribute__((ext_vector_type(4)));
typedef unsigned u32x2 __attribute__((ext_vector_type(2)));
constexpr int NB = 4, SEQ = 4096, DM = 1024, DEPTH = 4, DIN = 3072, NMEM = 256, MROWS = NB * SEQ;
constexpr int LDS_BYTES = 147456;
constexpr size_t MiB = 1u << 20;
constexpr size_t WS_WIN = 0;
constexpr size_t WS_WOUT = 24 * MiB;
constexpr size_t WS_WMEM = 32 * MiB;
constexpr size_t WS_XB = 36 * MiB;
constexpr size_t WS_MEMB = 68 * MiB;
constexpr size_t WS_QK = 70 * MiB;
constexpr size_t WS_VT = 118 * MiB;
constexpr size_t WS_KM = 134 * MiB;
constexpr size_t WS_VM = 136 * MiB;
constexpr size_t WS_G = 138 * MiB;
constexpr size_t WS_Y = 170 * MiB;
constexpr size_t WS_SSQ = 202 * MiB;
constexpr size_t WS_ROPE = 203 * MiB;
constexpr size_t WS_RSX = 204 * MiB;
constexpr size_t WS_RSM = 204 * MiB + 65536;
constexpr size_t WS_LAM = 204 * MiB + 131072;
constexpr size_t WS_BAR = 204 * MiB + 524288;
constexpr size_t WS_END = 205 * MiB;

DI float wave_sum(float v) {
#pragma unroll
    for (int o = 1; o < 64; o <<= 1) v += __shfl_xor(v, o);
    return v;
}
DI void transpose_item(const float* __restrict__ W, int K, int N, const float* __restrict__ gk, bf16_t* __restrict__ WT, bool headperm, LAS float* scr, int item, int lane) {
    const int nblk = N / 32, kb = item / nblk, nb = item % nblk, k0 = 64 * kb, n0 = 32 * nb;
    float wv[32];
#pragma unroll
    for (int i = 0; i < 32; ++i) wv[i] = W[(size_t)(k0 + 2 * i + (lane >> 5)) * N + n0 + (lane & 31)];
#pragma unroll
    for (int i = 0; i < 32; ++i) { const int kk = 2 * i + (lane >> 5); float w = wv[i]; if (gk) w *= gk[k0 + kk]; scr[kk * 33 + (lane & 31)] = w; }
    asm volatile("s_waitcnt lgkmcnt(0)" ::: "memory");
    int drow0 = n0; if (headperm) { const int w = n0 & 255; drow0 = (n0 & ~255) + 128 * ((w & 63) >> 5) + 32 * (w >> 6); }
    const int c = lane & 7;
#pragma unroll
    for (int j = 0; j < 4; ++j) { const int n = (lane >> 3) + 8 * j; const LAS float* s = scr + (8 * c) * 33 + n;
        u32x4 o; o.x = cvtpk(s[0 * 33], s[1 * 33]); o.y = cvtpk(s[2 * 33], s[3 * 33]); o.z = cvtpk(s[4 * 33], s[5 * 33]); o.w = cvtpk(s[6 * 33], s[7 * 33]);
        *(u32x4*)(WT + (size_t)(drow0 + n) * K + k0 + 8 * c) = o; }
    asm volatile("s_waitcnt lgkmcnt(0)" ::: "memory");
}
DI void row_update(const float* __restrict__ xin, const bf16_t* __restrict__ y, const float* __restrict__ ssq, const float* __restrict__ gpost, float* xout, bf16_t* xb, float* rs_out, int lane) {
    f32x4 v[4];
    if (xin) {
#pragma unroll
        for (int j = 0; j < 4; ++j) v[j] = *(const f32x4*)(xin + 4 * lane + 256 * j);
    } else {
#pragma unroll
        for (int j = 0; j < 4; ++j) { const u32x2 xx = *(const u32x2*)(xb + 4 * lane + 256 * j); v[j][0] = bf_lo(xx.x); v[j][1] = bf_hi(xx.x); v[j][2] = bf_lo(xx.y); v[j][3] = bf_hi(xx.y); }
    }
    if (y) {
        float sy = 0.f;
#pragma unroll
        for (int i = 0; i < 4; ++i) { const f32x4 q = *(const f32x4*)(ssq + 4 * i); sy += (q[0] + q[1]) + (q[2] + q[3]); }
        const float ry = rsqrtf(sy * (1.f / 1024.f) + NORM_EPS);
#pragma unroll
        for (int j = 0; j < 4; ++j) { const u32x2 yy = *(const u32x2*)(y + 4 * lane + 256 * j); const f32x4 g = *(const f32x4*)(gpost + 4 * lane + 256 * j);
            v[j][0] += bf_lo(yy.x) * ry * g[0]; v[j][1] += bf_hi(yy.x) * ry * g[1]; v[j][2] += bf_lo(yy.y) * ry * g[2]; v[j][3] += bf_hi(yy.y) * ry * g[3]; }
    }
    float s = 0.f;
#pragma unroll
    for (int j = 0; j < 4; ++j) s += (v[j][0] * v[j][0] + v[j][1] * v[j][1]) + (v[j][2] * v[j][2] + v[j][3] * v[j][3]);
    s = wave_sum(s);
    if (xout) {
#pragma unroll
        for (int j = 0; j < 4; ++j) *(f32x4*)(xout + 4 * lane + 256 * j) = v[j];
    } else {
#pragma unroll
        for (int j = 0; j < 4; ++j) { u32x2 w; w.x = cvtpk(v[j][0], v[j][1]); w.y = cvtpk(v[j][2], v[j][3]); *(u32x2*)(xb + 4 * lane + 256 * j) = w; }
        if (lane == 0) *rs_out = rsqrtf(s * (1.f / 1024.f) + NORM_EPS);
    }
}
template <int R>
DI void rows_update(const float* __restrict__ xin, const bf16_t* __restrict__ y, const float* __restrict__ ssq, const float* __restrict__ gpost, float* xout, bf16_t* xb, float* rs_out, int m0, int mstep, int lane) {
    f32x4 v[R][4]; u32x2 yy[R][4]; f32x4 q[R][4];
#pragma unroll
    for (int r = 0; r < R; ++r) { const size_t m = m0 + r * mstep;
        if (xin) {
#pragma unroll
            for (int j = 0; j < 4; ++j) v[r][j] = *(const f32x4*)(xin + m * DM + 4 * lane + 256 * j);
        } else {
#pragma unroll
            for (int j = 0; j < 4; ++j) { const u32x2 xx = *(const u32x2*)(xb + m * DM + 4 * lane + 256 * j); v[r][j][0] = bf_lo(xx.x); v[r][j][1] = bf_hi(xx.x); v[r][j][2] = bf_lo(xx.y); v[r][j][3] = bf_hi(xx.y); }
        }
        if (y) {
#pragma unroll
            for (int j = 0; j < 4; ++j) { yy[r][j] = *(const u32x2*)(y + m * DM + 4 * lane + 256 * j); q[r][j] = *(const f32x4*)(ssq + m * 16 + 4 * j); }
        }
    }
    if (y) {
#pragma unroll
        for (int r = 0; r < R; ++r) {
            float sy = 0.f;
#pragma unroll
            for (int i = 0; i < 4; ++i) sy += (q[r][i][0] + q[r][i][1]) + (q[r][i][2] + q[r][i][3]);
            const float ry = rsqrtf(sy * (1.f / 1024.f) + NORM_EPS);
#pragma unroll
            for (int j = 0; j < 4; ++j) { const f32x4 g = *(const f32x4*)(gpost + 4 * lane + 256 * j);
                v[r][j][0] += bf_lo(yy[r][j].x) * ry * g[0]; v[r][j][1] += bf_hi(yy[r][j].x) * ry * g[1]; v[r][j][2] += bf_lo(yy[r][j].y) * ry * g[2]; v[r][j][3] += bf_hi(yy[r][j].y) * ry * g[3]; }
        }
    }
#pragma unroll
    for (int r = 0; r < R; ++r) { const size_t m = m0 + r * mstep;
        float s = 0.f;
#pragma unroll
        for (int j = 0; j < 4; ++j) s += (v[r][j][0] * v[r][j][0] + v[r][j][1] * v[r][j][1]) + (v[r][j][2] * v[r][j][2] + v[r][j][3] * v[r][j][3]);
        s = wave_sum(s);
        if (xout) {
#pragma unroll
            for (int j = 0; j < 4; ++j) *(f32x4*)(xout + m * DM + 4 * lane + 256 * j) = v[r][j];
        } else {
#pragma unroll
            for (int j = 0; j < 4; ++j) { u32x2 w; w.x = cvtpk(v[r][j][0], v[r][j][1]); w.y = cvtpk(v[r][j][2], v[r][j][3]); *(u32x2*)(xb + m * DM + 4 * lane + 256 * j) = w; }
            if (lane == 0) rs_out[m] = rsqrtf(s * (1.f / 1024.f) + NORM_EPS);
        }
    }
}
DI void rope_entry(int idx, float2* out) {
    const int pos = idx >> 4, j = idx & 15;
    const int jl = j & 3, jh = j >> 2;
    const double ml = jl == 0 ? 1.0 : (jl == 1 ? 0.5623413251903491 : (jl == 2 ? 0.31622776601683794 : 0.1778279410038923));
    const double mh = jh == 0 ? 1.0 : (jh == 1 ? 0.1 : (jh == 2 ? 0.01 : 0.001));
    const float inv = (float)(ml * mh);
    const float angf = (float)pos * inv;
    const double a = (double)angf;
    const double kq = __builtin_rint(a * 0.63661977236758134308);
    double r = __builtin_fma(-kq, 1.57079632679489655800e+00, a); r = __builtin_fma(-kq, 6.12323399573676603587e-17, r);
    const int q = ((int)kq) & 3;
    const double r2 = r * r;
    const double sn = r * (1.0 + r2 * (-1.0 / 6 + r2 * (1.0 / 120 + r2 * (-1.0 / 5040 + r2 * (1.0 / 362880 + r2 * (-1.0 / 39916800 + r2 * (1.0 / 6227020800.0)))))));
    const double cs = 1.0 + r2 * (-0.5 + r2 * (1.0 / 24 + r2 * (-1.0 / 720 + r2 * (1.0 / 40320 + r2 * (-1.0 / 3628800 + r2 * (1.0 / 479001600.0 + r2 * (-1.0 / 87178291200.0)))))));
    const double c = q == 0 ? cs : (q == 1 ? -sn : (q == 2 ? -cs : sn));
    const double s = q == 0 ? sn : (q == 1 ? cs : (q == 2 ? -sn : -cs));
    *out = make_float2((float)c, (float)s);
}

#ifndef PROBE_REP
#define PROBE_REP 0
#endif
#ifndef PROBE_VAR
#define PROBE_VAR 0
#endif
#ifndef GQA_SPLIT
#define GQA_SPLIT 0
#endif
#ifndef SCHED_XCDHALF
#define SCHED_XCDHALF 1
#endif
#if PROBE_VAR == 2
#define ATT_CALL(D, ...) do { if (rep == 0) att::attn_unit<D, true>(__VA_ARGS__); else att::attn_unit<D, false>(__VA_ARGS__); } while (0)
#else
#define ATT_CALL(D, ...) do { if (!safe_pass) { if (att::attn_unit<D, false, true>(__VA_ARGS__)) redo |= 1u << unit_no; } else if ((redo >> unit_no) & 1u) att::attn_unit<D, false, false>(__VA_ARGS__); ++unit_no; } while (0)
#endif
#define XB_TMO      128
#define XB_XCNT(j)  (256  + 64 * (j))
#define XB_XSUB(j)  (1280 + 64 * (j))
#define XB_XGEN(j)  (2304 + 64 * (j))
#define XB_TOP      3328
#define XB_TOPGEN   3392
#define XCD_BAR_WORDS 3456
#define XB_SPIN_CAP (1u << 18)

__device__ __forceinline__ unsigned xb_ld(unsigned* p)              { return __hip_atomic_load(p, __ATOMIC_RELAXED, __HIP_MEMORY_SCOPE_AGENT); }
__device__ __forceinline__ unsigned xb_add(unsigned* p, unsigned v) { return __hip_atomic_fetch_add(p, v, __ATOMIC_RELAXED, __HIP_MEMORY_SCOPE_AGENT); }
__device__ __forceinline__ unsigned xb_xcc_id() { return (unsigned)__builtin_amdgcn_s_getreg((3 << 11) | 20) & 0xFu; }
#define XB_SPIN(cond, bar) do { unsigned _sp = 0; while (cond) { __builtin_amdgcn_s_sleep(1); \
    if ((++_sp & 255u) == 0u) { if (xb_ld(&(bar)[XB_TMO])) break; if (_sp > XB_SPIN_CAP) { atomicAdd(&(bar)[XB_TMO], 1u); break; } } } } while (0)

struct XcdBarrier {
    unsigned* bar; unsigned x;
    volatile LAS unsigned* st;
};

__device__ __forceinline__ XcdBarrier xcd_barrier_post(unsigned* bar, volatile LAS unsigned* st) {
    XcdBarrier b; b.bar = bar; b.x = xb_xcc_id(); b.st = st;
    if (threadIdx.x == 0) (void)xb_add(&bar[XB_XCNT(b.x)], 1u);
    return b;
}
__device__ __forceinline__ void xcd_barrier_complete(unsigned* bar, unsigned x, unsigned& nloc, unsigned& nx) {
    const unsigned G = gridDim.x * gridDim.y * gridDim.z;
    unsigned sum, cnt, mine, sp = 0u;
    for (;;) {
        sum = 0u; cnt = 0u; mine = 0u;
#pragma unroll
        for (unsigned j = 0; j < 16; ++j) { const unsigned c = xb_ld(&bar[XB_XCNT(j)]); sum += c; cnt += (c > 0u) ? 1u : 0u; mine = (j == x) ? c : mine; }
        if (sum == G) break;
        __builtin_amdgcn_s_sleep(1);
        if ((++sp & 255u) == 0u) { if (xb_ld(&bar[XB_TMO])) break; if (sp > XB_SPIN_CAP) { atomicAdd(&bar[XB_TMO], 1u); break; } }
    }
    nloc = mine > 0u ? mine : 1u; nx = cnt > 0u ? cnt : 1u;
}

__device__ __forceinline__ void xcd_barrier(const XcdBarrier& b, bool t0) {
    asm volatile("s_waitcnt vmcnt(0)" ::: "memory");
    __syncthreads();
    if (t0) {
        unsigned* bar = b.bar;
        __builtin_amdgcn_s_waitcnt(0);
        unsigned nloc = b.st[0], nx = b.st[1];
        if (nloc == 0u) { xcd_barrier_complete(bar, b.x, nloc, nx); b.st[0] = nloc; b.st[1] = nx; }
        const unsigned old = xb_add(&bar[XB_XSUB(b.x)], 1u);
        const unsigned gen = old / nloc;
        if (old + 1u == (gen + 1u) * nloc) {
            __builtin_amdgcn_fence(__ATOMIC_RELEASE, "agent");
            asm volatile("s_waitcnt vmcnt(0)" ::: "memory");
            const unsigned og = xb_add(&bar[XB_TOP], 1u);
            const unsigned tg = og / nx;
            if (og + 1u == (tg + 1u) * nx) xb_add(&bar[XB_TOPGEN], 1u);
            else XB_SPIN(xb_ld(&bar[XB_TOPGEN]) == tg, bar);
            __builtin_amdgcn_fence(__ATOMIC_ACQUIRE, "agent");
            xb_add(&bar[XB_XGEN(b.x)], 1u);
            asm volatile("s_waitcnt vmcnt(0)" ::: "memory");
        } else {
            XB_SPIN(xb_ld(&bar[XB_XGEN(b.x)]) == gen, bar);
            __builtin_amdgcn_fence(__ATOMIC_ACQUIRE, "agent");
            asm volatile("s_waitcnt vmcnt(0)" ::: "memory");
        }
    }
    __syncthreads();
}

struct Args { const float* in[12]; float* out; unsigned char* ws; int ph_lo, ph_hi; };
constexpr int N_PHASES = 1 + 4 * DEPTH;
constexpr int I_IN = 16 * 96, I_OUT = 16 * 32;

__global__ void __launch_bounds__(512, 2) fwd(Args a) {
    extern __shared__ __attribute__((aligned(16))) unsigned char lds_raw[];
    LAS unsigned char* lds = (LAS unsigned char*)lds_raw;
    cg::grid_group grid = cg::this_grid();
    const int wave_s = __builtin_amdgcn_readfirstlane(threadIdx.x >> 6);
    const int G = gridDim.x, bx = blockIdx.x;
    const int vcu = (G % 8 == 0) ? (bx % 8) * (G / 8) + bx / 8 : bx;
    const int lo = a.ph_lo, hi = a.ph_hi;
#define WS_PTRS() size_t wso_ = 0; asm volatile("" : "+s"(wso_)); unsigned char* ws = a.ws + wso_;     \
    const int lane = lane_now(), wave = wave_s, tid = (wave_s << 6) | lane; (void)lane; (void)wave; (void)tid; \
    bf16_t* WIN = (bf16_t*)(ws + WS_WIN); bf16_t* WOUT = (bf16_t*)(ws + WS_WOUT); bf16_t* WMEM = (bf16_t*)(ws + WS_WMEM); \
    bf16_t* XB = (bf16_t*)(ws + WS_XB); bf16_t* MEMB = (bf16_t*)(ws + WS_MEMB); bf16_t* QK = (bf16_t*)(ws + WS_QK); bf16_t* VT = (bf16_t*)(ws + WS_VT); \
    bf16_t* KM = (bf16_t*)(ws + WS_KM); bf16_t* VM = (bf16_t*)(ws + WS_VM); bf16_t* GB = (bf16_t*)(ws + WS_G); bf16_t* YB = (bf16_t*)(ws + WS_Y); \
    float* SSQ = (float*)(ws + WS_SSQ); float2* ROPE = (float2*)(ws + WS_ROPE); float* RSX = (float*)(ws + WS_RSX); float* RSM = (float*)(ws + WS_RSM); float* LAM = (float*)(ws + WS_LAM); \
    (void)WIN; (void)WOUT; (void)WMEM; (void)XB; (void)MEMB; (void)QK; (void)VT; (void)KM; (void)VM; (void)GB; (void)YB; (void)SSQ; (void)ROPE; (void)RSX; (void)RSM; (void)LAM;
#define RUN(k) (lo <= (k) && (k) < hi)
#if PROBE_REP == 4
#define SEAM(k) do { if (RUN(k) && RUN((k) + 1)) { xcd_barrier(xbar, wave_s == 0 && lane_now() == 0); xcd_barrier(xbar, wave_s == 0 && lane_now() == 0); } } while (0)
#else
#define SEAM(k) do { if (RUN(k) && RUN((k) + 1)) xcd_barrier(xbar, wave_s == 0 && lane_now() == 0); } while (0)
#endif

    if (threadIdx.x < 2) ((volatile LAS unsigned*)(lds + 131072 + 64))[threadIdx.x] = 0u;
    __syncthreads();
    if (RUN(0)) { WS_PTRS();
        if (bx == 0) for (int i = tid; i < XCD_BAR_WORDS; i += 512) __hip_atomic_store((unsigned*)(ws + WS_BAR) + i, 0u, __ATOMIC_RELAXED, __HIP_MEMORY_SCOPE_AGENT);
        if (bx == 0 && wave < DEPTH) {
            const float* lp = a.in[4] + wave * 128; const int li = lane & 31;
            const float p1 = lp[li] * lp[32 + li], p2 = lp[64 + li] * lp[96 + li];
            const float s1 = wave_sum(lane < 32 ? p1 : 0.f), s2 = wave_sum(lane < 32 ? p2 : 0.f);
            if (lane == 0) LAM[wave] = expf(s1) - expf(s2) + (0.8f - 0.6f * expf(-0.3f * (float)wave));
        }
        LAS float* scr = (LAS float*)(lds + wave * 16384);
        const int gw = vcu * 8 + wave, NGW = G * 8;
        constexpr int I_MEM = 16 * 16, NITEMS0 = DEPTH * I_MEM + I_IN + I_OUT;
#if PROBE_REP == 6
        for (int rep = 0; rep < 2; ++rep) {
#else
        {
#endif
        for (int it = gw; it < NITEMS0; it += NGW) {
            int r = it;
            if (r < DEPTH * I_MEM) { const int l = r / I_MEM; r -= l * I_MEM;
                transpose_item(a.in[9] + (size_t)l * DM * 512, DM, 512, a.in[8] + l * DM, WMEM + (size_t)l * 512 * DM, true, scr, r, lane); continue; }
            r -= DEPTH * I_MEM;
            if (r < I_IN) transpose_item(a.in[3], DM, DIN, a.in[2], WIN, true, scr, r, lane);
            else transpose_item(a.in[10], DM, DM, nullptr, WOUT, false, scr, r - I_IN, lane);
        }
        for (int m = gw; m < MROWS; m += 2 * NGW) rows_update<2>(a.in[0], nullptr, nullptr, nullptr, nullptr, XB, RSX, m, NGW, lane);
        for (int m = gw; m < NB * NMEM; m += NGW) row_update(a.in[1] + (size_t)m * DM, nullptr, nullptr, nullptr, nullptr, MEMB + (size_t)m * DM, RSM + m, lane);
        }
        for (int i = (vcu * 512 + tid); i < 4096 * 16; i += G * 512) rope_entry(i, ROPE + i);

    }
    XcdBarrier xbar; xbar.bar = (unsigned*)(a.ws + WS_BAR); xbar.x = 0; xbar.st = (volatile LAS unsigned*)(lds + 131072 + 64);
    if (RUN(0) && RUN(1)) { grid.sync(); xbar = xcd_barrier_post((unsigned*)(a.ws + WS_BAR), (volatile LAS unsigned*)(lds + 131072 + 64)); }

    for (int l = 0; l < DEPTH; ++l) {
        const int p0 = 1 + 4 * l;
        if (RUN(p0)) { WS_PTRS();
            { pg8::Gemm g{XB, WIN + (size_t)l * DIN * DM, MROWS, DIN, DM}; pg8::StaticOrder S; S.init(MROWS, DIN, G, bx);
              pg8::EpiIn E{RSX, QK, VT, GB, ROPE, a.in[6] + l * 64, a.in[7] + l * 64};
#if PROBE_REP == 1
              for (int rep = 0; rep < 2; ++rep)
#endif
              pg8::gemm_phase<pg8::EpiIn, pg8::StaticOrder, true, true>(lds, g, S, E, wave_s);
            }
            if (l == 0) { pg8::Gemm g{MEMB, WMEM, NB * NMEM, DEPTH * 512, DM}; pg8::StaticOrder S; S.init(NB * NMEM, DEPTH * 512, G, (bx + G - 32) % G);
              pg8::EpiMemKV E{RSM, KM, VM};
              pg8::gemm_phase<pg8::EpiMemKV, pg8::StaticOrder, true, true>(lds, g, S, E, wave_s); }
        }
        SEAM(p0);
        if (RUN(p0 + 1)) { WS_PTRS();
#if PROBE_REP == 2
            for (int rep = 0; rep < 2; ++rep)
#else
            const int rep = 1;
#endif
#if SCHED_XCDHALF
            unsigned redo = 0u;
            for (int safe_pass = 0; safe_pass < 2; ++safe_pass) { int unit_no = 0; if (safe_pass && !redo) break;
            for (int idx = vcu; idx < 768; idx += G) {
                if (idx < 384) { const int bh = idx >> 4, qb = idx & 15, b = bh / 6, h = bh % 6;
                    ATT_CALL(true, lds, QK + ((size_t)(b * 24 + h) * SEQ + qb * 256) * 64, QK + (size_t)(b * 24 + 6 + h) * SEQ * 64, VT + (size_t)(b * 8 + h) * 64 * SEQ, SEQ,
                                         GB + ((size_t)b * SEQ + qb * 256) * DM + h * 64, LAM + l, a.in[5] + l * 64, l, rep == 0, wave_s);
                } else { const int i = idx - 384, bh = i >> 4, qb = i & 15, b = bh / 6, h = bh % 6, kvh = h / 3;
                    ATT_CALL(false, lds, QK + ((size_t)(b * 24 + 12 + h) * SEQ + qb * 256) * 64, QK + (size_t)(b * 24 + 18 + kvh) * SEQ * 64, VT + (size_t)(b * 8 + 6 + kvh) * 64 * SEQ, SEQ,
                                          GB + ((size_t)b * SEQ + qb * 256) * DM + 384 + h * 64, nullptr, nullptr, l, rep == 0, wave_s);
                }
            }
            if (vcu >= 128) for (int k = 0; k < 2; ++k) { const int i = 2 * (vcu - 128) + k, bh = i >> 4, qb = i & 15, b = bh >> 2, h = bh & 3;
                ATT_CALL(false, lds, QK + ((size_t)(b * 24 + 20 + h) * SEQ + qb * 256) * 64, KM + (size_t)((l * 4 + b) * 4 + h) * NMEM * 64, VM + (size_t)((l * 4 + b) * 4 + h) * 64 * NMEM, NMEM,
                                      GB + ((size_t)b * SEQ + qb * 256) * DM + 768 + h * 64, nullptr, nullptr, l, rep == 0, wave_s); }
            }
            const bool light_wg = vcu >= 128; const int light_ix = vcu - 128;
#else
            {
                const int x = vcu >> 5, j = vcu & 31, heavy = j < 16;
                for (int k = 0; k < (heavy ? 2 : 1); ++k) {
                    const int du = heavy ? j + 16 * k : 32 + (j - 16), bh = 3 * x + (du >> 4), qb = du & 15, b = bh / 6, h = bh % 6;
                    ATT_CALL(true, lds, QK + ((size_t)(b * 24 + h) * SEQ + qb * 256) * 64, QK + (size_t)(b * 24 + 6 + h) * SEQ * 64, VT + (size_t)(b * 8 + h) * 64 * SEQ, SEQ,
                                         GB + ((size_t)b * SEQ + qb * 256) * DM + h * 64, LAM + l, a.in[5] + l * 64, l, rep == 0, wave_s);
                }
#if GQA_SPLIT
                { const int b = x >> 1, kvh = x & 1, ng = heavy ? 1 : 5, g0 = heavy ? j : 16 + 5 * (j - 16);
                  for (int k = 0; k < ng; ++k) { const int gu = g0 + k, h = kvh * 3 + (gu >> 5), q128 = gu & 31;
                    att::attn_unit_split(lds, QK + ((size_t)(b * 24 + 12 + h) * SEQ + q128 * 128) * 64, QK + (size_t)(b * 24 + 18 + kvh) * SEQ * 64, VT + (size_t)(b * 8 + 6 + kvh) * 64 * SEQ, SEQ,
                                         GB + ((size_t)b * SEQ + q128 * 128) * DM + 384 + h * 64, rep == 0, wave_s); } }
#else
                { const int b = x >> 1, kvh = x & 1, ng = heavy ? 1 : 2, g0 = heavy ? j : 16 + 2 * (j - 16);
                  for (int k = 0; k < ng; ++k) { const int gu = g0 + k, h = kvh * 3 + (gu >> 4), qb = gu & 15;
                    ATT_CALL(false, lds, QK + ((size_t)(b * 24 + 12 + h) * SEQ + qb * 256) * 64, QK + (size_t)(b * 24 + 18 + kvh) * SEQ * 64, VT + (size_t)(b * 8 + 6 + kvh) * 64 * SEQ, SEQ,
                                         GB + ((size_t)b * SEQ + qb * 256) * DM + 384 + h * 64, nullptr, nullptr, l, rep == 0, wave_s); } }
#endif
                if (GQA_SPLIT ? heavy : !heavy) for (int k = 0; k < 2; ++k) { const int i = x * 32 + 2 * (j & 15) + k, bh = i >> 4, qb = i & 15, b = bh >> 2, h = bh & 3;
                    ATT_CALL(false, lds, QK + ((size_t)(b * 24 + 20 + h) * SEQ + qb * 256) * 64, KM + (size_t)((l * 4 + b) * 4 + h) * NMEM * 64, VM + (size_t)((l * 4 + b) * 4 + h) * 64 * NMEM, NMEM,
                                          GB + ((size_t)b * SEQ + qb * 256) * DM + 768 + h * 64, nullptr, nullptr, l, rep == 0, wave_s); }
            }
            const bool light_wg = (vcu & 31) >= 16; const int light_ix = (vcu >> 5) * 16 + ((vcu & 31) - 16);
#endif
            if (l + 1 < DEPTH && light_wg) {
                __syncthreads();
                LAS float* scr = (LAS float*)(lds + wave * 16384);
                const int lw_ = light_ix * 8 + wave;
                for (int it = lw_; it < I_IN + I_OUT; it += 1024) {
                    if (it < I_IN) transpose_item(a.in[3] + (size_t)(l + 1) * DM * DIN, DM, DIN, a.in[2] + (l + 1) * DM, WIN + (size_t)(l + 1) * DIN * DM, true, scr, it, lane);
                    else transpose_item(a.in[10] + (size_t)(l + 1) * DM * DM, DM, DM, nullptr, WOUT + (size_t)(l + 1) * DM * DM, false, scr, it - I_IN, lane);
                }
            }
        }
        SEAM(p0 + 1);
        if (RUN(p0 + 2)) { WS_PTRS();
            pg8::Gemm g{GB, WOUT + (size_t)l * DM * DM, MROWS, DM, DM}; pg8::StaticOrder S; S.init(MROWS, DM, G, bx);
            pg8::EpiOut E{YB, SSQ};
            pg8::gemm_phase<pg8::EpiOut, pg8::StaticOrder, true, true>(lds, g, S, E, wave_s);
#if PROBE_REP == 3
            pg8::gemm_phase<pg8::EpiOut, pg8::StaticOrder, true, true>(lds, g, S, E, wave_s);
#endif
        }
        SEAM(p0 + 2);
        if (RUN(p0 + 3)) { WS_PTRS();
            const int gw = vcu * 8 + wave, NGW = G * 8;
#if PROBE_REP == 5
            for (int m = gw; m < MROWS; m += NGW)
                row_update(l == 0 ? a.in[0] + (size_t)m * DM : nullptr, YB + (size_t)m * DM, SSQ + (size_t)m * 16, a.in[11] + l * DM, (float*)(ws + WS_QK) + (size_t)m * DM, XB + (size_t)m * DM, (float*)(ws + WS_RSX + 262144) + m, lane);
#endif
            for (int m = gw; m < MROWS; m += 2 * NGW)
                rows_update<2>(l == 0 ? a.in[0] : nullptr, YB, SSQ, a.in[11] + l * DM, l == DEPTH - 1 ? a.out : nullptr, XB, RSX, m, NGW, lane);
        }
        SEAM(p0 + 3);
    }
}

extern "C" void kernel_launch(void* const* d_in, const int* in_sizes, int n_in, void* d_out, int out_size, void* d_ws, size_t ws_size, hipStream_t stream) {
    static int grid = 0;
    if (grid == 0) {
        if (n_in != 12 || ws_size < WS_END) { fprintf(stderr, "kernel_launch: unexpected problem (n_in %d, ws %zu)\n", n_in, ws_size); grid = -1; return; }
        int dev = 0, cus = 0, per_cu = 0;
        hipGetDevice(&dev); hipDeviceGetAttribute(&cus, hipDeviceAttributeMultiprocessorCount, dev);
        if (hipFuncSetAttribute((const void*)fwd, hipFuncAttributeMaxDynamicSharedMemorySize, LDS_BYTES) != hipSuccess) { fprintf(stderr, "kernel_launch: hipFuncSetAttribute failed\n"); grid = -1; return; }
        if (hipOccupancyMaxActiveBlocksPerMultiprocessor(&per_cu, (const void*)fwd, 512, LDS_BYTES) != hipSuccess || per_cu < 1) { fprintf(stderr, "kernel_launch: occupancy query says %d blocks per CU\n", per_cu); per_cu = 1; }
        (void)hipGetLastError();
        grid = 256;
        if (cus < 256) fprintf(stderr, "kernel_launch: %d CUs < 256: the cooperative launch will be refused\n", cus);
    }
    if (grid < 0) return;
    Args a{};
    for (int i = 0; i < 12; ++i) a.in[i] = (const float*)d_in[i];
    a.out = (float*)d_out; a.ws = (unsigned char*)d_ws;
#if ONE_LAUNCH
    a.ph_lo = 0; a.ph_hi = N_PHASES;
    void* args[] = {&a};
    hipError_t e = hipLaunchCooperativeKernel((const void*)fwd, dim3(grid), dim3(512), args, LDS_BYTES, stream);
    if (e != hipSuccess) fprintf(stderr, "kernel_launch: cooperative launch failed: %s (grid %d)\n", hipGetErrorString(e), grid);
#else
    for (int k = 0; k < N_PHASES; ++k) { a.ph_lo = k; a.ph_hi = k + 1; hipLaunchKernelGGL(fwd, dim3(grid), dim3(512), LDS_BYTES, stream, a); }
#endif
}
```

```cpp
#include <hip/hip_runtime.h>
#include <hip/hip_cooperative_groups.h>
#include <cstdio>
#include <cstdint>
namespace cg = cooperative_groups;
#ifndef ONE_LAUNCH
#define ONE_LAUNCH 1
#endif
#define DI __device__ __forceinline__
typedef float f32x2_t __attribute__((ext_vector_type(2)));
typedef __bf16 bf16x2_t __attribute__((ext_vector_type(2)));
DI unsigned cvtpk(float lo, float hi) { f32x2_t v = {lo, hi}; bf16x2_t b = __builtin_convertvector(v, bf16x2_t); return __builtin_bit_cast(unsigned, b); }
DI float bf_lo(unsigned u) { return __uint_as_float(u << 16); }
DI float bf_hi(unsigned u) { return __uint_as_float(u & 0xffff0000u); }
constexpr float NORM_EPS = 1e-6f;
constexpr float LOG2E = 1.4426950408889634f;
constexpr float SC_D = 0.17677669529663687f * LOG2E;
constexpr float SC_G = 0.125f * LOG2E;
DI int vpos(int t) { const int k = t & 15; return (t & ~15) | (((k >> 2) & 1) << 3) | ((k >> 3) << 2) | (k & 3); }
DI int lane_now() { int l; asm volatile("v_mbcnt_lo_u32_b32 %0, -1, 0\n\tv_mbcnt_hi_u32_b32 %0, -1, %0" : "=v"(l)); return l; }
typedef float f32x4 __attribute__((ext_vector_type(4)));
namespace pg8 {
#define PG8_LAS __attribute__((address_space(3)))
typedef unsigned short bf16_t;
typedef short bf16x8 __attribute__((ext_vector_type(8)));
typedef float f32x4 __attribute__((ext_vector_type(4)));
typedef unsigned u32x4 __attribute__((ext_vector_type(4)));
constexpr int BM = 256, BK = 64, HALF = 128, HTB = HALF * BK * 2  , STAGE_BYTES = 8 * HTB, NXCD = 8, WGM = 8;

__host__ __device__ __forceinline__ int lds_byte(int r, int c) { const int st = (r >> 4) * 2 + (c >> 5), rr = r & 15, cc = c & 31, ob = rr * 64 + cc * 2; return st * 1024 + (ob ^ (((ob >> 9) & 1) << 5)); }
__host__ __device__ __forceinline__ void stage_rc(int b, int& R, int& C) { const int st = b / 1024, sb = b % 1024, swz = sb ^ (((sb >> 9) & 1) << 5); R = (st >> 1) * 16 + swz / 64; C = (st & 1) * 32 + (swz % 64) / 2; }
__host__ __device__ __forceinline__ int perm32(int rho) { const int n = rho >> 4, i = rho & 15; return 8 * (i >> 2) + 4 * n + (i & 3); }

struct Unit { int pm, pn; };
struct Gemm { const bf16_t* A; const bf16_t* Bt; int M, N, K; };

struct StaticOrder {
    int nM, nN, nwg, G, c;
    __host__ __device__ void init(int M, int N, int G_, int c_) { nM = M / BM; nN = N / BM; nwg = nM * nN; G = G_; c = c_; }
    __host__ __device__ bool next(int i, Unit& u) const {
        const long L = (long)i * G + c; if (L >= nwg) return false;
        int wgid = (int)L; { const int q = nwg / NXCD, r = nwg % NXCD, xcd = wgid % NXCD, off = wgid / NXCD; wgid = (xcd < r ? xcd * (q + 1) : r * (q + 1) + (xcd - r) * q) + off; }
        const int nig = WGM * nN, gid = wgid / nig, fm = gid * WGM, gsz = (nM - fm) < WGM ? (nM - fm) : WGM;
        u.pm = fm + ((wgid % nig) % gsz); u.pn = (wgid % nig) / gsz; return true;
    }
    __device__ __forceinline__ void a_ready(const Unit&) const {}
    __device__ __forceinline__ void done(const Unit&) const {}
};

typedef float2 rope_t;
DI void rope8(float (&v)[8], const rope_t* cs, int fq, float sc) {
    const f32x4 c0 = *(const f32x4*)(cs), c1 = *(const f32x4*)(cs + 2), c2 = *(const f32x4*)(cs + 4), c3 = *(const f32x4*)(cs + 6);
    const float cc[8] = {c0[0], c0[2], c1[0], c1[2], c2[0], c2[2], c3[0], c3[2]}, ss[8] = {c0[1], c0[3], c1[1], c1[3], c2[1], c2[3], c3[1], c3[3]};
#pragma unroll
    for (int j = 0; j < 8; ++j) { auto rr = __builtin_amdgcn_permlane32_swap(__float_as_uint(v[j]), __float_as_uint(v[j]), false, false);
        const float p = __uint_as_float(fq < 2 ? rr[1] : rr[0]); const float sp = fq < 2 ? -p : p; v[j] = (v[j] * cc[j] + sp * ss[j]) * sc; }
}
DI void store8(bf16_t* p, const float (&v)[8]) { u32x4 w; w.x = cvtpk(v[0], v[1]); w.y = cvtpk(v[2], v[3]); w.z = cvtpk(v[4], v[5]); w.w = cvtpk(v[6], v[7]); *(u32x4*)p = w; }
DI float silu(float x) { return x * __builtin_amdgcn_rcpf(1.f + __expf(-x)); }

struct EpiIn {
    static constexpr bool PERM = true, AFTER_DRAIN = false;
    const float* rs; bf16_t* QK; bf16_t* VT; bf16_t* G; const rope_t* rope; const float* gqn; const float* gkn;
    DI void operator()(const f32x4 (&acc)[2][2][4][2], const Unit& u, int wr, int wc, int fr, int fq) const {
        const int g64 = u.pn * 4 + wc;
#pragma unroll
        for (int ai = 0; ai < 2; ++ai)
#pragma unroll
            for (int m = 0; m < 4; ++m) {
                const int row = u.pm * BM + ai * HALF + wr * 64 + m * 16 + fr, b = row >> 12, t = row & 4095;
                const float rsv = rs[row];
                float v[2][8];
#pragma unroll
                for (int bj = 0; bj < 2; ++bj)
#pragma unroll
                    for (int n = 0; n < 2; ++n)
#pragma unroll
                        for (int i = 0; i < 4; ++i) v[bj][4 * n + i] = acc[ai][bj][m][n][i] * rsv;
                if (g64 < 12) {
                    const float sc = g64 < 6 ? SC_D : 1.f;
                    const rope_t* cs = rope + t * 16 + 8 * (fq & 1);
                    bf16_t* dst = QK + ((size_t)(b * 24 + g64) * 4096 + t) * 64 + 8 * fq;
#pragma unroll
                    for (int bj = 0; bj < 2; ++bj) { rope8(v[bj], cs, fq, sc); store8(dst + 32 * bj, v[bj]); }
                } else if (g64 < 18 || (g64 >= 32 && g64 < 34)) {
                    const int hv = g64 < 18 ? g64 - 12 : g64 - 32 + 6;
                    const bool odd = fr & 1;
                    bf16_t* dst = VT + ((size_t)(b * 8 + hv) * 64 + 8 * fq) * 4096 + vpos(t & ~1);
#pragma unroll
                    for (int bj = 0; bj < 2; ++bj)
#pragma unroll
                        for (int j2 = 0; j2 < 4; ++j2) {
                            const float mine = odd ? v[bj][2 * j2 + 1] : v[bj][2 * j2], send = odd ? v[bj][2 * j2] : v[bj][2 * j2 + 1];
                            const float got = __shfl_xor(send, 1);
                            const unsigned w = odd ? cvtpk(got, mine) : cvtpk(mine, got);
                            *(unsigned*)(dst + (size_t)(32 * bj + 2 * j2 + (odd ? 1 : 0)) * 4096) = w; }
                } else if (g64 < 24 || (g64 >= 34 && g64 < 40) || g64 >= 44) {
                    const int col = g64 < 24 ? (g64 - 18) * 64 : (g64 < 40 ? 384 + (g64 - 34) * 64 : 768 + (g64 - 44) * 64);
                    bf16_t* dst = G + (size_t)row * 1024 + col + 8 * fq;
#pragma unroll
                    for (int bj = 0; bj < 2; ++bj) {
#pragma unroll
                        for (int j = 0; j < 8; ++j) v[bj][j] = silu(v[bj][j]);
                        store8(dst + 32 * bj, v[bj]); }
                } else if (g64 < 32) {
                    float ss = 0.f;
#pragma unroll
                    for (int bj = 0; bj < 2; ++bj)
#pragma unroll
                        for (int j = 0; j < 8; ++j) ss += v[bj][j] * v[bj][j];
                    ss += __shfl_xor(ss, 16); ss += __shfl_xor(ss, 32);
                    const float r = rsqrtf(ss * (1.f / 64.f) + NORM_EPS);
                    const bool isq = g64 < 30; const float* gw = (isq ? gqn : gkn) + 8 * fq;
                    const int slot = isq ? 12 + (g64 - 24) : 18 + (g64 - 30);
                    bf16_t* dst = QK + ((size_t)(b * 24 + slot) * 4096 + t) * 64 + 8 * fq;
#pragma unroll
                    for (int bj = 0; bj < 2; ++bj) {
#pragma unroll
                        for (int j = 0; j < 8; ++j) v[bj][j] *= r * gw[32 * bj + j];
                        const int pos = bj == 0 ? (t >> 6) : (t & 63);
                        rope8(v[bj], rope + pos * 16 + 8 * (fq & 1), fq, isq ? SC_G : 1.f);
                        store8(dst + 32 * bj, v[bj]); }
                } else {
                    bf16_t* dst = QK + ((size_t)(b * 24 + 20 + (g64 - 40)) * 4096 + t) * 64 + 8 * fq;
#pragma unroll
                    for (int bj = 0; bj < 2; ++bj) {
#pragma unroll
                        for (int j = 0; j < 8; ++j) v[bj][j] *= SC_G;
                        store8(dst + 32 * bj, v[bj]); }
                }
                if (m == 3) asm volatile("" ::: "memory");
            }
    }
};

struct EpiMemKV {
    static constexpr bool PERM = true, AFTER_DRAIN = false;
    const float* rs; bf16_t* KM; bf16_t* VM;
    DI void operator()(const f32x4 (&acc)[2][2][4][2], const Unit& u, int wr, int wc, int fr, int fq) const {
        const int l = u.pn >> 1, isv = u.pn & 1;
#pragma unroll
        for (int ai = 0; ai < 2; ++ai)
#pragma unroll
            for (int m = 0; m < 4; ++m) {
                const int row = u.pm * BM + ai * HALF + wr * 64 + m * 16 + fr, b = row >> 8, t = row & 255;
                const float rsv = rs[row];
                float v[2][8];
#pragma unroll
                for (int bj = 0; bj < 2; ++bj)
#pragma unroll
                    for (int n = 0; n < 2; ++n)
#pragma unroll
                        for (int i = 0; i < 4; ++i) v[bj][4 * n + i] = acc[ai][bj][m][n][i] * rsv;
                const size_t hb = (size_t)((l * 4 + b) * 4 + wc);
                if (!isv) { bf16_t* dst = KM + (hb * 256 + t) * 64 + 8 * fq;
#pragma unroll
                    for (int bj = 0; bj < 2; ++bj) store8(dst + 32 * bj, v[bj]);
                } else { bf16_t* dst = VM + (hb * 64 + 8 * fq) * 256 + vpos(t);
#pragma unroll
                    for (int bj = 0; bj < 2; ++bj)
#pragma unroll
                        for (int j = 0; j < 8; ++j) dst[(size_t)(32 * bj + j) * 256] = (bf16_t)(cvtpk(v[bj][j], 0.f) & 0xffffu); }
                asm volatile("" ::: "memory");
            }
    }
};

struct EpiOut {
    static constexpr bool PERM = true, AFTER_DRAIN = false;
    bf16_t* Y; float* ssq;
    DI void operator()(const f32x4 (&acc)[2][2][4][2], const Unit& u, int wr, int wc, int fr, int fq) const {
#pragma unroll
        for (int ai = 0; ai < 2; ++ai)
#pragma unroll
            for (int m = 0; m < 4; ++m) {
                const int row = u.pm * BM + ai * HALF + wr * 64 + m * 16 + fr;
                float v[2][8]; float ss = 0.f;
#pragma unroll
                for (int bj = 0; bj < 2; ++bj)
#pragma unroll
                    for (int n = 0; n < 2; ++n)
#pragma unroll
                        for (int i = 0; i < 4; ++i) { const float x = acc[ai][bj][m][n][i]; v[bj][4 * n + i] = x; ss += x * x; }
                ss += __shfl_xor(ss, 16); ss += __shfl_xor(ss, 32);
                if (fq == 0) ssq[(size_t)row * 16 + u.pn * 4 + wc] = ss;
                bf16_t* dst = Y + (size_t)row * 1024 + u.pn * BM + wc * 32 + 8 * fq;
#pragma unroll
                for (int bj = 0; bj < 2; ++bj) store8(dst + bj * HALF, v[bj]);
                asm volatile("" ::: "memory");
            }
    }
};

template <class Epi, class Sched, bool ALIGN_EPI = false, bool SP2 = false>
__device__ __forceinline__ void gemm_phase(PG8_LAS unsigned char* lds, const Gemm g, const Sched& S, const Epi& E, int wave_s) {
    const int tid_ = (wave_s << 6) | lane_now();
    const int tid = tid_, wid = __builtin_amdgcn_readfirstlane(tid >> 6), lane = tid & 63, wr = wid >> 2, wc = wid & 3, fr = lane & 15, fq = lane >> 4;
    const int K = g.K, nt = K / BK;
    unsigned voffA[2], voffB[2];
#pragma unroll
    for (int i = 0; i < 2; ++i) { int R, C; stage_rc(tid * 16 + i * 8192, R, C); const int Rb = Epi::PERM ? ((R & ~31) + perm32(R & 31)) : R;
        voffA[i] = (unsigned)(R * K + C) * 2u; voffB[i] = (unsigned)(Rb * K + C) * 2u; }
    const size_t kstep = (size_t)(BK * 2);
    const size_t hstep = (size_t)HALF * K * 2;
    const size_t tstep = 2 * hstep;
    const unsigned ldsw = (unsigned)wid * 1024u;
    const int aoff = lds_byte(wr * 64 + fr, fq * 8), boff = lds_byte(wc * 32 + fr, fq * 8);
#define PG8_SA(b, h) (((b) * 2 + (h)) * HTB)
#define PG8_SB(b, h) ((4 + (b) * 2 + (h)) * HTB)
#define PG8_STAGE(bufoff, gbase, voff) do { _Pragma("unroll") for (int _i = 0; _i < 2; ++_i) \
        __builtin_amdgcn_global_load_lds((const unsigned*)((const char*)(gbase) + (voff)[_i]), (PG8_LAS unsigned*)(lds + (bufoff) + ldsw + _i * 8192), 16, 0, 0); } while (0)
#define PG8_LDA(dst, b, h) do { _Pragma("unroll") for (int m = 0; m < 4; ++m) _Pragma("unroll") for (int k = 0; k < 2; ++k) dst[m][k] = *(const PG8_LAS bf16x8*)(lds + PG8_SA(b, h) + aoff + m * 2048 + k * 1024); } while (0)
#define PG8_LDB(dst, b, h) do { _Pragma("unroll") for (int n = 0; n < 2; ++n) _Pragma("unroll") for (int k = 0; k < 2; ++k) dst[n][k] = *(const PG8_LAS bf16x8*)(lds + PG8_SB(b, h) + boff + n * 2048 + k * 1024); } while (0)
#define PG8_MMA(ai, bj, At, Bt) do { __builtin_amdgcn_s_setprio(1); _Pragma("unroll") for (int m = 0; m < 4; ++m) _Pragma("unroll") for (int n = 0; n < 2; ++n) _Pragma("unroll") for (int k = 0; k < 2; ++k) \
        acc[ai][bj][m][n] = __builtin_amdgcn_mfma_f32_16x16x32_bf16(Bt[n][k], At[m][k], acc[ai][bj][m][n], 0, 0, 0); __builtin_amdgcn_s_setprio(0); } while (0)
#define PG8_WAIT_V(n) asm volatile("s_waitcnt vmcnt(" #n ")" ::: "memory")
#define PG8_WAIT_L(n) asm volatile("s_waitcnt lgkmcnt(" #n ")" ::: "memory")
#define PG8_BAR __builtin_amdgcn_s_barrier()
#define PG8_SCHED __builtin_amdgcn_sched_barrier(0)
    Unit cur, nxt; int ui = 0;
    if (!S.next(0, cur)) return;
    f32x4 acc[2][2][4][2];
#pragma unroll
    for (int a = 0; a < 2; ++a)
#pragma unroll
        for (int b = 0; b < 2; ++b)
#pragma unroll
            for (int m = 0; m < 4; ++m)
#pragma unroll
                for (int n = 0; n < 2; ++n) acc[a][b][m][n] = (f32x4){0.f, 0.f, 0.f, 0.f};
    bf16x8 At[4][2], B0[2][2], B1[2][2];
    const char* cA = (const char*)g.A + (size_t)cur.pm * tstep; const char* cB = (const char*)g.Bt + (size_t)cur.pn * tstep;
    S.a_ready(cur);
    if constexpr (SP2) {
        PG8_STAGE(PG8_SB(0, 0), cB, voffB); PG8_STAGE(PG8_SB(0, 1), cB + hstep, voffB); PG8_STAGE(PG8_SA(0, 0), cA, voffA); PG8_STAGE(PG8_SA(0, 1), cA + hstep, voffA);
        if (wr == 1) PG8_BAR;
        PG8_WAIT_V(2); PG8_BAR;
        PG8_STAGE(PG8_SB(1, 0), cB + kstep, voffB); PG8_STAGE(PG8_SA(1, 0), cA + kstep, voffA); PG8_STAGE(PG8_SB(1, 1), cB + hstep + kstep, voffB);
        PG8_WAIT_V(6); PG8_BAR;
    } else {
        PG8_STAGE(PG8_SB(0, 0), cB, voffB); PG8_STAGE(PG8_SA(0, 0), cA, voffA); PG8_STAGE(PG8_SB(0, 1), cB + hstep, voffB); PG8_STAGE(PG8_SA(0, 1), cA + hstep, voffA);
        if (wr == 1) PG8_BAR;
        PG8_WAIT_V(4); PG8_BAR;
        PG8_STAGE(PG8_SB(1, 0), cB + kstep, voffB); PG8_STAGE(PG8_SA(1, 0), cA + kstep, voffA); PG8_STAGE(PG8_SB(1, 1), cB + hstep + kstep, voffB);
        PG8_WAIT_V(6); PG8_BAR;
    }
    for (;;) {
        const bool has_next = S.next(ui + 1, nxt);
        const char* nA = has_next ? (const char*)g.A + (size_t)nxt.pm * tstep : cA; const char* nB = has_next ? (const char*)g.Bt + (size_t)nxt.pn * tstep : cB;
        for (int t = 0; t < nt; t += 2) {
            const bool last = (t == nt - 2);
            const char* a1 = cA + (size_t)(t + 1) * kstep;
            const char* a2 = last ? nA : cA + (size_t)(t + 2) * kstep; const char* b2 = last ? nB : cB + (size_t)(t + 2) * kstep;
            const char* a3 = a2 + kstep; const char* b3 = b2 + kstep;
            if (last && has_next) S.a_ready(nxt);
            if constexpr (SP2) {
            PG8_LDB(B0, 0, 0); PG8_LDB(B1, 0, 1); PG8_SCHED; PG8_LDA(At, 0, 0); PG8_STAGE(PG8_SA(1, 1), a1 + hstep, voffA);
            PG8_WAIT_V(8); PG8_WAIT_L(0); PG8_BAR; PG8_MMA(0, 0, At, B0); PG8_MMA(0, 1, At, B1); PG8_BAR; PG8_SCHED;
            PG8_LDA(At, 0, 1); PG8_STAGE(PG8_SB(0, 0), b2, voffB); PG8_STAGE(PG8_SB(0, 1), b2 + hstep, voffB); PG8_STAGE(PG8_SA(0, 0), a2, voffA);
            PG8_WAIT_V(8); PG8_WAIT_L(0); PG8_BAR; PG8_MMA(1, 0, At, B0); PG8_MMA(1, 1, At, B1); PG8_BAR; PG8_SCHED;
            PG8_LDB(B0, 1, 0); PG8_LDB(B1, 1, 1); PG8_SCHED; PG8_LDA(At, 1, 0); PG8_STAGE(PG8_SA(0, 1), a2 + hstep, voffA);
            PG8_WAIT_V(8); PG8_WAIT_L(0); PG8_BAR; PG8_MMA(0, 0, At, B0); PG8_MMA(0, 1, At, B1); PG8_BAR; PG8_SCHED;
            PG8_LDA(At, 1, 1); PG8_STAGE(PG8_SB(1, 0), b3, voffB); PG8_STAGE(PG8_SB(1, 1), b3 + hstep, voffB); PG8_STAGE(PG8_SA(1, 0), a3, voffA);
            PG8_WAIT_V(8); PG8_WAIT_L(0); PG8_BAR; PG8_MMA(1, 0, At, B0); PG8_MMA(1, 1, At, B1); PG8_BAR; PG8_SCHED;
            } else {
            PG8_LDB(B0, 0, 0); PG8_SCHED; PG8_LDA(At, 0, 0); PG8_STAGE(PG8_SA(1, 1), a1 + hstep, voffA);
            PG8_WAIT_L(8); PG8_BAR; PG8_WAIT_L(0); PG8_MMA(0, 0, At, B0); PG8_BAR; PG8_SCHED;
            PG8_LDB(B1, 0, 1); PG8_STAGE(PG8_SB(0, 0), b2, voffB);
            PG8_BAR; PG8_WAIT_L(0); PG8_MMA(0, 1, At, B1); PG8_BAR;
            PG8_LDA(At, 0, 1); PG8_STAGE(PG8_SA(0, 0), a2, voffA);
            PG8_BAR; PG8_WAIT_L(0); PG8_MMA(1, 0, At, B0); PG8_BAR; PG8_SCHED;
            PG8_STAGE(PG8_SB(0, 1), b2 + hstep, voffB);
            PG8_WAIT_V(6); PG8_BAR; PG8_MMA(1, 1, At, B1); PG8_BAR;
            PG8_LDB(B0, 1, 0); PG8_SCHED; PG8_LDA(At, 1, 0); PG8_STAGE(PG8_SA(0, 1), a2 + hstep, voffA);
            PG8_WAIT_L(8); PG8_BAR; PG8_WAIT_L(0); PG8_MMA(0, 0, At, B0); PG8_BAR; PG8_SCHED;
            PG8_LDB(B1, 1, 1); PG8_STAGE(PG8_SB(1, 0), b3, voffB);
            PG8_BAR; PG8_WAIT_L(0); PG8_MMA(0, 1, At, B1); PG8_BAR;
            PG8_LDA(At, 1, 1); PG8_STAGE(PG8_SA(1, 0), a3, voffA);
            PG8_BAR; PG8_WAIT_L(0); PG8_MMA(1, 0, At, B0); PG8_BAR; PG8_SCHED;
            PG8_STAGE(PG8_SB(1, 1), b3 + hstep, voffB);
            PG8_WAIT_V(6); PG8_BAR; PG8_MMA(1, 1, At, B1); PG8_BAR;
            }
        }
        if constexpr (ALIGN_EPI) { if (wr == 0) PG8_BAR; }
        if constexpr (!Epi::AFTER_DRAIN) { E(acc, cur, wr, wc, fr, fq); S.done(cur); }
        if (!has_next) break;
#pragma unroll
        for (int a = 0; a < 2; ++a)
#pragma unroll
            for (int b = 0; b < 2; ++b)
#pragma unroll
                for (int m = 0; m < 4; ++m)
#pragma unroll
                    for (int n = 0; n < 2; ++n) acc[a][b][m][n] = (f32x4){0.f, 0.f, 0.f, 0.f};
        cur = nxt; cA = nA; cB = nB; ++ui;
        if constexpr (ALIGN_EPI) { if (wr == 1) PG8_BAR; }
    }
    PG8_WAIT_V(0);
    if constexpr (!ALIGN_EPI) { if (wr == 0) PG8_BAR; }
    PG8_BAR;
    if constexpr (Epi::AFTER_DRAIN) { E.fused(acc, cur, wr, wc, fr, fq, lds, wid, lane); S.done(cur); }
#undef PG8_SA
#undef PG8_SB
#undef PG8_STAGE
#undef PG8_LDA
#undef PG8_LDB
#undef PG8_MMA
#undef PG8_WAIT_V
#undef PG8_WAIT_L
#undef PG8_BAR
#undef PG8_SCHED
}
}
#undef LAS
namespace att {
#define LAS __attribute__((address_space(3)))
typedef unsigned short bf16_t;
typedef short bf16x8 __attribute__((ext_vector_type(8)));
typedef float f32x16 __attribute__((ext_vector_type(16)));
typedef unsigned u32x4 __attribute__((ext_vector_type(4)));
typedef unsigned u32x2 __attribute__((ext_vector_type(2)));
typedef float f32x4 __attribute__((ext_vector_type(4)));
typedef float f32x4s __attribute__((ext_vector_type(4)));
constexpr int ROWB = 144, SLOT = 64 * ROWB;
constexpr int KOFF = 0, VOFF = 3 * SLOT;
constexpr int ATT_LDS = 5 * SLOT;
constexpr float THR = 8.f;
#ifndef PROBE_FORCE_REDO
#define PROBE_FORCE_REDO 0
#endif
#ifndef PROBE_NOMAX
#define PROBE_NOMAX 0
#endif
#define MFMA32(a, b, c) __builtin_amdgcn_mfma_f32_32x32x16_bf16((a), (b), (c), 0, 0, 0)
DI float hmax(float m) { auto rr = __builtin_amdgcn_permlane32_swap(__float_as_uint(m), __float_as_uint(m), false, false); return __builtin_fmaxf(__uint_as_float(rr[0]), __uint_as_float(rr[1])); }
DI float hsum(float m) { auto rr = __builtin_amdgcn_permlane32_swap(__float_as_uint(m), __float_as_uint(m), false, false); return __uint_as_float(rr[0]) + __uint_as_float(rr[1]); }
DI f32x16 splat16(float v) { return (f32x16){v, v, v, v, v, v, v, v, v, v, v, v, v, v, v, v}; }
DI float mx3(float a, float b, float c) { return __builtin_fmaxf(__builtin_fmaxf(a, b), c); }
DI float rowmax(const f32x16& p0, const f32x16& p1) {
    const float NEG = -3.0e38f;
    float a = mx3(NEG, p0[0], p0[1]), b = mx3(NEG, p1[0], p1[1]);
#pragma unroll
    for (int r = 2; r < 16; r += 2) { a = mx3(a, p0[r], p0[r + 1]); b = mx3(b, p1[r], p1[r + 1]); }
    a = __builtin_fmaxf(a, b);
    auto rr = __builtin_amdgcn_permlane32_swap(__float_as_uint(a), __float_as_uint(a), false, false);
    return mx3(NEG, __uint_as_float(rr[0]), __uint_as_float(rr[1]));
}
DI void reference(f32x16& p0, f32x16& p1, float& mref, float& l, f32x16& negm, f32x16& o0, f32x16& o1, bool first, f32x16* ls = nullptr, f32x4s* l4 = nullptr) {
#if PROBE_NOMAX
    if (!first) return;
#endif
    const float mx = rowmax(p0, p1);
    if (first) {
        mref = mx;
#pragma unroll
        for (int r = 0; r < 16; ++r) { p0[r] -= mx; p1[r] -= mx; }
        negm = splat16(-mx);
    } else if (__any(mx > THR)) {
        const float dl = __builtin_fmaxf(mx, 0.f);
        mref += dl;
        const float al = __builtin_amdgcn_exp2f(-dl);
        l *= al;
#pragma unroll
        for (int r = 0; r < 16; ++r) { p0[r] -= dl; p1[r] -= dl; o0[r] *= al; o1[r] *= al; }
        if (ls) { (*ls)[0] *= al; }
        if (l4) { (*l4)[0] *= al; }
        negm = splat16(-mref);
    }
}
template <int DS0, int NDS>
DI void qk_issue(f32x16& n0, f32x16& n1, const LAS unsigned char* kb, const bf16x8 (&qf)[4], const f32x16& c) {
#pragma unroll
    for (int ds = DS0; ds < DS0 + NDS; ++ds) {
        const bf16x8 a0 = *(const LAS bf16x8*)(kb + ds * 32), a1 = *(const LAS bf16x8*)(kb + 32 * ROWB + ds * 32);
        if (ds == DS0) { n0 = MFMA32(a0, qf[ds], c); n1 = MFMA32(a1, qf[ds], c); }
        else { n0 = MFMA32(a0, qf[ds], n0); n1 = MFMA32(a1, qf[ds], n1); } }
}
template <bool NOEXP = false, bool SUM = true>
DI void exp_pack(f32x16& p0, f32x16& p1, float& l, bf16x8 (&pb)[4]) {
#pragma unroll
    for (int r = 0; r < 16; ++r) { if (NOEXP) { p0[r] = p0[r] * 0.001f; p1[r] = p1[r] * 0.001f; } else { p0[r] = __builtin_amdgcn_exp2f(p0[r]); p1[r] = __builtin_amdgcn_exp2f(p1[r]); } }
    if (SUM) {
    float s0 = 0.f, s1 = 0.f;
#pragma unroll
    for (int r = 0; r < 16; r += 2) { s0 += p0[r] + p1[r]; s1 += p0[r + 1] + p1[r + 1]; }
    l += s0 + s1; }
    u32x4 w;
    w.x = cvtpk(p0[0], p0[1]); w.y = cvtpk(p0[2], p0[3]); w.z = cvtpk(p0[4], p0[5]); w.w = cvtpk(p0[6], p0[7]); pb[0] = __builtin_bit_cast(bf16x8, w);
    w.x = cvtpk(p0[8], p0[9]); w.y = cvtpk(p0[10], p0[11]); w.z = cvtpk(p0[12], p0[13]); w.w = cvtpk(p0[14], p0[15]); pb[1] = __builtin_bit_cast(bf16x8, w);
    w.x = cvtpk(p1[0], p1[1]); w.y = cvtpk(p1[2], p1[3]); w.z = cvtpk(p1[4], p1[5]); w.w = cvtpk(p1[6], p1[7]); pb[2] = __builtin_bit_cast(bf16x8, w);
    w.x = cvtpk(p1[8], p1[9]); w.y = cvtpk(p1[10], p1[11]); w.z = cvtpk(p1[12], p1[13]); w.w = cvtpk(p1[14], p1[15]); pb[3] = __builtin_bit_cast(bf16x8, w);
}
DI void pv_issue(f32x16& o0, f32x16& o1, const LAS unsigned char* vb, const bf16x8 (&pb)[4]) {
#pragma unroll
    for (int s = 0; s < 4; ++s) {
        const bf16x8 v0 = *(const LAS bf16x8*)(vb + s * 32), v1 = *(const LAS bf16x8*)(vb + 32 * ROWB + s * 32);
        o0 = MFMA32(v0, pb[s], o0); o1 = MFMA32(v1, pb[s], o1); }
}

template <int DS0, int NDS>
DI void kload(bf16x8 (&kf)[2 * NDS], const LAS unsigned char* kb) {
#pragma unroll
    for (int i = 0; i < NDS; ++i) { kf[2 * i] = *(const LAS bf16x8*)(kb + (DS0 + i) * 32); kf[2 * i + 1] = *(const LAS bf16x8*)(kb + 32 * ROWB + (DS0 + i) * 32); }
}
template <int DS0, int NDS>
DI void qk_mma(f32x16& n0, f32x16& n1, const bf16x8 (&kf)[2 * NDS], const bf16x8 (&qf)[4], const f32x16& c) {
#pragma unroll
    for (int i = 0; i < NDS; ++i) {
        if (i == 0) { n0 = MFMA32(kf[0], qf[DS0], c); n1 = MFMA32(kf[1], qf[DS0], c); }
        else { n0 = MFMA32(kf[2 * i], qf[DS0 + i], n0); n1 = MFMA32(kf[2 * i + 1], qf[DS0 + i], n1); } }
}
DI void vload(bf16x8 (&vf)[8], const LAS unsigned char* vb) {
#pragma unroll
    for (int s = 0; s < 4; ++s) { vf[2 * s] = *(const LAS bf16x8*)(vb + s * 32); vf[2 * s + 1] = *(const LAS bf16x8*)(vb + 32 * ROWB + s * 32); }
}
DI void pv_mma(f32x16& o0, f32x16& o1, const bf16x8 (&vf)[8], const bf16x8 (&pb)[4]) {
#pragma unroll
    for (int s = 0; s < 4; ++s) { o0 = MFMA32(vf[2 * s], pb[s], o0); o1 = MFMA32(vf[2 * s + 1], pb[s], o1); }
}
DI void pv_mma_sum(f32x16& o0, f32x16& o1, f32x16& ls, const bf16x8 (&vf)[8], const bf16x8 (&pb)[4]) {
    const bf16x8 ones = {0x3f80, 0x3f80, 0x3f80, 0x3f80, 0x3f80, 0x3f80, 0x3f80, 0x3f80};
#pragma unroll
    for (int s = 0; s < 4; ++s) { o0 = MFMA32(vf[2 * s], pb[s], o0); o1 = MFMA32(vf[2 * s + 1], pb[s], o1); ls = MFMA32(ones, pb[s], ls); }
}
#define SBAR() __builtin_amdgcn_sched_barrier(0)

DI void e8(f32x16& p, int base_is_8, bf16x8& pb) {
    u32x4 w;
    if (!base_is_8) { _Pragma("unroll") for (int r = 0; r < 8; ++r) p[r] = __builtin_amdgcn_exp2f(p[r]);
        w.x = cvtpk(p[0], p[1]); w.y = cvtpk(p[2], p[3]); w.z = cvtpk(p[4], p[5]); w.w = cvtpk(p[6], p[7]); }
    else { _Pragma("unroll") for (int r = 8; r < 16; ++r) p[r] = __builtin_amdgcn_exp2f(p[r]);
        w.x = cvtpk(p[8], p[9]); w.y = cvtpk(p[10], p[11]); w.z = cvtpk(p[12], p[13]); w.w = cvtpk(p[14], p[15]); }
    pb = __builtin_bit_cast(bf16x8, w);
}
DI void half_step_std(f32x16& c0, f32x16& c1, f32x16& n0, f32x16& n1, const bf16x8 (&kf)[8], const bf16x8 (&vf)[8], const bf16x8 (&qf)[4], const f32x16& ng,
                      f32x16& o0, f32x16& o1, f32x16& ls) {
    const bf16x8 ones = {0x3f80, 0x3f80, 0x3f80, 0x3f80, 0x3f80, 0x3f80, 0x3f80, 0x3f80};
    bf16x8 pb0, pb1, pb2, pb3;
    SBAR();
    e8(c0, 0, pb0);
    n0 = MFMA32(kf[0], qf[0], ng); n1 = MFMA32(kf[1], qf[0], ng);
    SBAR();
    e8(c0, 1, pb1);
    n0 = MFMA32(kf[2], qf[1], n0); n1 = MFMA32(kf[3], qf[1], n1);
    o0 = MFMA32(vf[0], pb0, o0); o1 = MFMA32(vf[1], pb0, o1); ls = MFMA32(ones, pb0, ls);
    SBAR();
    e8(c1, 0, pb2);
    n0 = MFMA32(kf[4], qf[2], n0); n1 = MFMA32(kf[5], qf[2], n1);
    o0 = MFMA32(vf[2], pb1, o0); o1 = MFMA32(vf[3], pb1, o1); ls = MFMA32(ones, pb1, ls);
    SBAR();
    e8(c1, 1, pb3);
    n0 = MFMA32(kf[6], qf[3], n0); n1 = MFMA32(kf[7], qf[3], n1);
    o0 = MFMA32(vf[4], pb2, o0); o1 = MFMA32(vf[5], pb2, o1); ls = MFMA32(ones, pb2, ls);
    SBAR();
    o0 = MFMA32(vf[6], pb3, o0); o1 = MFMA32(vf[7], pb3, o1); ls = MFMA32(ones, pb3, ls);
}

DI bf16x8 sum_selector(int lane) {
    const int row = lane & 15, g = lane >> 4;
    const bool on = ((row == 0 || row == 8) && (g == 0 || g == 2)) || ((row == 4 || row == 12) && (g == 1 || g == 3));
    const short v = on ? (short)0x3f80 : (short)0;
    return (bf16x8){v, v, v, v, v, v, v, v};
}
#define MFMA16(a, b, c) __builtin_amdgcn_mfma_f32_16x16x32_bf16((a), (b), (c), 0, 0, 0)

DI void pv_mma_sel(f32x16& o0, f32x16& o1, f32x4s& l4, const bf16x8& asel, const bf16x8 (&vf)[8], const bf16x8 (&pb)[4]) {
#pragma unroll
    for (int s = 0; s < 4; ++s) { o0 = MFMA32(vf[2 * s], pb[s], o0); o1 = MFMA32(vf[2 * s + 1], pb[s], o1); l4 = MFMA16(asel, pb[s], l4); }
}

DI void e8s(f32x16& p, int hi8, bf16x8& pb, float& l) {
    u32x4 w; float s;
    if (!hi8) { _Pragma("unroll") for (int r = 0; r < 8; ++r) p[r] = __builtin_amdgcn_exp2f(p[r]);
        s = ((p[0] + p[1]) + (p[2] + p[3])) + ((p[4] + p[5]) + (p[6] + p[7]));
        w.x = cvtpk(p[0], p[1]); w.y = cvtpk(p[2], p[3]); w.z = cvtpk(p[4], p[5]); w.w = cvtpk(p[6], p[7]); }
    else { _Pragma("unroll") for (int r = 8; r < 16; ++r) p[r] = __builtin_amdgcn_exp2f(p[r]);
        s = ((p[8] + p[9]) + (p[10] + p[11])) + ((p[12] + p[13]) + (p[14] + p[15]));
        w.x = cvtpk(p[8], p[9]); w.y = cvtpk(p[10], p[11]); w.z = cvtpk(p[12], p[13]); w.w = cvtpk(p[14], p[15]); }
    l += s; pb = __builtin_bit_cast(bf16x8, w);
}
template <int DS0>
DI void half_step_diff(f32x16& c0, f32x16& c1, f32x16& n0, f32x16& n1, const bf16x8 (&kf)[4], const bf16x8 (&vf)[8], const bf16x8 (&qf)[4], const f32x16& ng,
                       f32x16& o0, f32x16& o1, f32x4s& l4, const bf16x8& asel) {
    bf16x8 pb0, pb1, pb2, pb3;
    SBAR();
    e8(c0, 0, pb0);
    n0 = MFMA32(kf[0], qf[DS0], ng); n1 = MFMA32(kf[1], qf[DS0], ng);
    SBAR();
    e8(c0, 1, pb1);
    n0 = MFMA32(kf[2], qf[DS0 + 1], n0); n1 = MFMA32(kf[3], qf[DS0 + 1], n1);
    o0 = MFMA32(vf[0], pb0, o0); o1 = MFMA32(vf[1], pb0, o1); l4 = MFMA16(asel, pb0, l4);
    SBAR();
    e8(c1, 0, pb2);
    o0 = MFMA32(vf[2], pb1, o0); o1 = MFMA32(vf[3], pb1, o1); l4 = MFMA16(asel, pb1, l4);
    SBAR();
    e8(c1, 1, pb3);
    o0 = MFMA32(vf[4], pb2, o0); o1 = MFMA32(vf[5], pb2, o1); l4 = MFMA16(asel, pb2, l4);
    SBAR();
    o0 = MFMA32(vf[6], pb3, o0); o1 = MFMA32(vf[7], pb3, o1); l4 = MFMA16(asel, pb3, l4);
}

template <bool DIFF, bool NOEXP = false, bool FAST = false>
DI bool attn_unit(LAS unsigned char* lds, const bf16_t* __restrict__ Qp, const bf16_t* __restrict__ Kp, const bf16_t* __restrict__ Vtp, int nk, bf16_t* Gp,
                  const float* lamp, const float* subln, int layer, bool dry, int wave_s) {
    const int tid_ = (wave_s << 6) | lane_now();
    const int tid = tid_, lane = tid & 63, r32 = lane & 31, hi = lane >> 5; const int wid = __builtin_amdgcn_readfirstlane(tid >> 6);
    bf16x8 qf[4];
    { const bf16_t* qrow = Qp + (size_t)(wid * 32 + r32) * 64 + hi * 8;
#pragma unroll
      for (int ds = 0; ds < 4; ++ds) qf[ds] = *(const bf16x8*)(qrow + ds * 16); }
    const int lrow = tid >> 3, lch = tid & 7;
    const bf16_t* kg = Kp + (size_t)lrow * 64 + lch * 8;
    const bf16_t* vg = Vtp + (size_t)lrow * nk + lch * 8;
    const unsigned lw = lrow * ROWB + lch * 16;
    const int NT = nk >> 6;
    u32x4 kreg, vreg;
    { const u32x4 k0 = *(const u32x4*)kg, v0 = *(const u32x4*)vg, k1 = *(const u32x4*)(kg + 4096);
      *(LAS u32x4*)(lds + KOFF + lw) = k0; *(LAS u32x4*)(lds + VOFF + lw) = v0; *(LAS u32x4*)(lds + KOFF + SLOT + lw) = k1; }
    kreg = *(const u32x4*)(kg + (size_t)2 * 4096); vreg = *(const u32x4*)(vg + 64);
    __syncthreads();
    float m1 = 0.f, l1 = 0.f, m2 = 0.f, l2 = 0.f;
    f32x16 oa0, oa1, ob0, ob1, ng1, ng2;
#pragma unroll
    for (int r = 0; r < 16; ++r) { oa0[r] = 0.f; oa1[r] = 0.f; ob0[r] = 0.f; ob1[r] = 0.f; }
    ng1 = splat16(0.f); ng2 = splat16(0.f);
    const unsigned fro = r32 * ROWB + hi * 16;
    f32x16 pa0, pa1, pc0, pc1;
    qk_issue<0, DIFF ? 2 : 4>(pa0, pa1, lds + KOFF + fro, qf, ng1);
    int kc = 0, kn = SLOT, kw = 2 * SLOT;
#ifndef PROBE_VAR
#define PROBE_VAR 0
#endif
#define STAGE(t) do { if (PROBE_VAR == 1 && dry) { const int o_ = kc; kc = kn; kn = kw; kw = o_; break; } *(LAS u32x4*)(lds + KOFF + kw + lw) = kreg; *(LAS u32x4*)(lds + VOFF + (((t) + 1) & 1) * SLOT + lw) = vreg; \
        { const int tk = (t) + 3 < NT ? (t) + 3 : NT - 1, tv = (t) + 2 < NT ? (t) + 2 : NT - 1; \
          kreg = *(const u32x4*)(kg + (size_t)tk * 4096); vreg = *(const u32x4*)(vg + (size_t)tv * 64); } \
        { const int o_ = kc; kc = kn; kn = kw; kw = o_; } \
        __syncthreads(); } while (0)
    if (DIFF) {
        f32x4s l4a = {0.f, 0.f, 0.f, 0.f}, l4b = {0.f, 0.f, 0.f, 0.f};
        const bf16x8 asel = sum_selector(lane);
        for (int t = 0; t < NT; ++t) {
            bf16x8 pb[4], kf[4], vf[8];
            kload<2, 2>(kf, lds + KOFF + kc + fro);
            if (!FAST) reference(pa0, pa1, m1, l1, ng1, oa0, oa1, t == 0, nullptr, &l4a);
            vload(vf, lds + VOFF + (t & 1) * SLOT + fro);
            { const f32x16 c = splat16(FAST ? 0.f : -m2);
              half_step_diff<2>(pa0, pa1, pc0, pc1, kf, vf, qf, c, oa0, oa1, l4a, asel); }
            SBAR();
            kload<0, 2>(kf, lds + KOFF + kn + fro);
            if (!FAST) reference(pc0, pc1, m2, l2, ng2, ob0, ob1, t == 0, nullptr, &l4b);

            { const f32x16 c = splat16(FAST ? 0.f : -m1);
              half_step_diff<0>(pc0, pc1, pa0, pa1, kf, vf, qf, c, ob0, ob1, l4b, asel); }
            STAGE(t);
        }
        l1 = 0.5f * l4a[0]; l2 = 0.5f * l4b[0];
    } else {
        f32x4s l4s = {0.f, 0.f, 0.f, 0.f};
        const bf16x8 asel = sum_selector(lane);
#define HALF_STD(CUR0, CUR1, NXT0, NXT1, t) do { bf16x8 pb[4], kf[8], vf[8]; \
            kload<0, 4>(kf, lds + KOFF + kn + fro); vload(vf, lds + VOFF + ((t) & 1) * SLOT + fro); \
            if (!FAST) reference(CUR0, CUR1, m1, l1, ng1, oa0, oa1, (t) == 0, nullptr, &l4s); \
            qk_mma<0, 4>(NXT0, NXT1, kf, qf, ng1); \
            exp_pack<NOEXP, false>(CUR0, CUR1, l1, pb); \
            pv_mma_sel(oa0, oa1, l4s, asel, vf, pb); \
            STAGE(t); } while (0)
        for (int t = 0; t < NT; t += 2) {
            HALF_STD(pa0, pa1, pc0, pc1, t);
            HALF_STD(pc0, pc1, pa0, pa1, t + 1);
        }
#undef HALF_STD
        l1 = 0.5f * l4s[0];
    }
#undef STAGE
    if (FAST) {
        bool bad = !(l1 < 1.0e30f && l1 > 1.0e-30f);
        if (DIFF) bad = bad || !(l2 < 1.0e30f && l2 > 1.0e-30f);
#if PROBE_FORCE_REDO
        bad = bad || ((wid & 1) == 0 && r32 == 3);
#endif
        LAS unsigned* fl = (LAS unsigned*)(lds + ATT_LDS);
        if (lane == 0) fl[wid] = 0u;
        if (__any(bad) && lane == 0) fl[wid] = 1u;
        __syncthreads();
        unsigned anyb = 0u;
#pragma unroll
        for (int w = 0; w < 8; ++w) anyb |= fl[w];
        if (anyb) return true;
    }
    const float inv1 = 1.f / hsum(l1);
    f32x16 oA[2] = {oa0, oa1};
    LAS unsigned char* stg = lds + 49152 + wid * 8704;
    if (DIFF) {
        const float lam = *lamp, out_scale = 1.f - (0.8f - 0.6f * __expf(-0.3f * (float)layer));
        const float inv2 = lam / hsum(l2);
        float ss = 0.f;
#pragma unroll
        for (int dh = 0; dh < 2; ++dh)
#pragma unroll
            for (int r = 0; r < 16; ++r) { const float x = oA[dh][r] * inv1 - (dh == 0 ? ob0[r] : ob1[r]) * inv2; oA[dh][r] = x; ss += x * x; }
        ss = hsum(ss);
        const float rn = rsqrtf(ss * (1.f / 64.f) + NORM_EPS) * out_scale;
#pragma unroll
        for (int dh = 0; dh < 2; ++dh)
#pragma unroll
            for (int g = 0; g < 4; ++g) {
                const int d0 = 32 * dh + 8 * g + 4 * hi;
                const f32x4 sw = *(const f32x4*)(subln + d0);
                *(LAS f32x4*)(stg + r32 * 272 + d0 * 4) = (f32x4){oA[dh][4 * g] * rn * sw[0], oA[dh][4 * g + 1] * rn * sw[1], oA[dh][4 * g + 2] * rn * sw[2], oA[dh][4 * g + 3] * rn * sw[3]}; }
    } else {
#pragma unroll
        for (int dh = 0; dh < 2; ++dh)
#pragma unroll
            for (int g = 0; g < 4; ++g)
                *(LAS f32x4*)(stg + r32 * 272 + (32 * dh + 8 * g + 4 * hi) * 4) = (f32x4){oA[dh][4 * g] * inv1, oA[dh][4 * g + 1] * inv1, oA[dh][4 * g + 2] * inv1, oA[dh][4 * g + 3] * inv1};
    }
    { bf16_t* gbase = Gp + (size_t)(wid * 32) * 1024;
      u32x4 gg[4];
#pragma unroll
      for (int k = 0; k < 4; ++k) { const int j = lane + 64 * k; gg[k] = *(const u32x4*)(gbase + (size_t)(j >> 3) * 1024 + (j & 7) * 8); }
#pragma unroll
      for (int k = 0; k < 4; ++k) { const int j = lane + 64 * k, row = j >> 3, c8 = j & 7;
          const f32x4 a = *(const LAS f32x4*)(stg + row * 272 + c8 * 32), b = *(const LAS f32x4*)(stg + row * 272 + c8 * 32 + 16);
          u32x4 w; w.x = cvtpk(a[0] * bf_lo(gg[k].x), a[1] * bf_hi(gg[k].x)); w.y = cvtpk(a[2] * bf_lo(gg[k].y), a[3] * bf_hi(gg[k].y));
          w.z = cvtpk(b[0] * bf_lo(gg[k].z), b[1] * bf_hi(gg[k].z)); w.w = cvtpk(b[2] * bf_lo(gg[k].w), b[3] * bf_hi(gg[k].w));
          if (!dry) *(u32x4*)(gbase + (size_t)row * 1024 + c8 * 8) = w; } }
    return false;
}

DI void attn_unit_split(LAS unsigned char* lds, const bf16_t* __restrict__ Qp, const bf16_t* __restrict__ Kp, const bf16_t* __restrict__ Vtp, int nk, bf16_t* Gp, bool dry, int wave_s) {
    const int tid_ = (wave_s << 6) | lane_now();
    const int tid = tid_, lane = tid & 63, r32 = lane & 31, hi = lane >> 5; const int wid = __builtin_amdgcn_readfirstlane(tid >> 6);
    const int grp = wid >> 2, wq = wid & 3;
    bf16x8 qf[4];
    { const bf16_t* qrow = Qp + (size_t)(wq * 32 + r32) * 64 + hi * 8;
#pragma unroll
      for (int ds = 0; ds < 4; ++ds) qf[ds] = *(const bf16x8*)(qrow + ds * 16); }
    const int NT = nk >> 7;
    const int gt = tid & 255, lrow = gt >> 3, lch = gt & 7;
    const bf16_t* kg = Kp + ((size_t)grp * NT * 64 + lrow) * 64 + lch * 8;
    const bf16_t* vg = Vtp + (size_t)lrow * nk + grp * NT * 64 + lch * 8;
    LAS unsigned char* ring = lds + grp * ATT_LDS;
    const unsigned lw = lrow * ROWB + lch * 16;
    u32x4 kreg0, kreg1, vreg0, vreg1;
    { const u32x4 k0 = *(const u32x4*)kg, k0b = *(const u32x4*)(kg + 32 * 64), v0 = *(const u32x4*)vg, v0b = *(const u32x4*)(vg + (size_t)32 * nk);
      const u32x4 k1 = *(const u32x4*)(kg + 4096), k1b = *(const u32x4*)(kg + 4096 + 32 * 64);
      *(LAS u32x4*)(ring + KOFF + lw) = k0; *(LAS u32x4*)(ring + KOFF + 32 * ROWB + lw) = k0b; *(LAS u32x4*)(ring + VOFF + lw) = v0; *(LAS u32x4*)(ring + VOFF + 32 * ROWB + lw) = v0b;
      *(LAS u32x4*)(ring + KOFF + SLOT + lw) = k1; *(LAS u32x4*)(ring + KOFF + SLOT + 32 * ROWB + lw) = k1b; }
    kreg0 = *(const u32x4*)(kg + (size_t)2 * 4096); kreg1 = *(const u32x4*)(kg + (size_t)2 * 4096 + 32 * 64);
    vreg0 = *(const u32x4*)(vg + 64); vreg1 = *(const u32x4*)(vg + (size_t)32 * nk + 64);
    __syncthreads();
    float m1 = 0.f, l1 = 0.f;
    f32x16 oa0, oa1, ng1 = splat16(0.f), ls = splat16(0.f);
#pragma unroll
    for (int r = 0; r < 16; ++r) { oa0[r] = 0.f; oa1[r] = 0.f; }
    const unsigned fro = r32 * ROWB + hi * 16;
    f32x16 pa0, pa1, pc0, pc1;
    { bf16x8 kf[8]; kload<0, 4>(kf, ring + KOFF + fro); qk_mma<0, 4>(pa0, pa1, kf, qf, ng1); }
    int kc = 0, kn = SLOT, kw = 2 * SLOT;
#define STAGE2(t) do { *(LAS u32x4*)(ring + KOFF + kw + lw) = kreg0; *(LAS u32x4*)(ring + KOFF + kw + 32 * ROWB + lw) = kreg1; \
        *(LAS u32x4*)(ring + VOFF + (((t) + 1) & 1) * SLOT + lw) = vreg0; *(LAS u32x4*)(ring + VOFF + (((t) + 1) & 1) * SLOT + 32 * ROWB + lw) = vreg1; \
        { const int tk = (t) + 3 < NT ? (t) + 3 : NT - 1, tv = (t) + 2 < NT ? (t) + 2 : NT - 1; \
          kreg0 = *(const u32x4*)(kg + (size_t)tk * 4096); kreg1 = *(const u32x4*)(kg + (size_t)tk * 4096 + 32 * 64); \
          vreg0 = *(const u32x4*)(vg + (size_t)tv * 64); vreg1 = *(const u32x4*)(vg + (size_t)32 * nk + (size_t)tv * 64); } \
        { const int o_ = kc; kc = kn; kn = kw; kw = o_; } \
        __syncthreads(); } while (0)
#define HALF_SPL(CUR0, CUR1, NXT0, NXT1, t) do { bf16x8 pb[4], kf[8], vf[8]; \
        kload<0, 4>(kf, ring + KOFF + kn + fro); vload(vf, ring + VOFF + ((t) & 1) * SLOT + fro); \
        reference(CUR0, CUR1, m1, l1, ng1, oa0, oa1, (t) == 0, &ls); \
        qk_mma<0, 4>(NXT0, NXT1, kf, qf, ng1); \
        exp_pack<false, false>(CUR0, CUR1, l1, pb); \
        pv_mma_sum(oa0, oa1, ls, vf, pb); \
        STAGE2(t); } while (0)
    for (int t = 0; t < NT; t += 2) {
        HALF_SPL(pa0, pa1, pc0, pc1, t);
        HALF_SPL(pc0, pc1, pa0, pa1, t + 1);
    }
#undef HALF_SPL
#undef STAGE2
    LAS float* mb = (LAS float*)lds + (wq * 64 + lane) * 35;
    if (grp == 1) {
        mb[0] = m1; mb[1] = ls[0];
#pragma unroll
        for (int r = 0; r < 16; ++r) { mb[2 + r] = oa0[r]; mb[18 + r] = oa1[r]; }
    }
    __syncthreads();
    if (grp == 0) {
        const float mB = mb[0], lB = mb[1];
        const float mm = __builtin_fmaxf(m1, mB), fa = __builtin_amdgcn_exp2f(m1 - mm), fb = __builtin_amdgcn_exp2f(mB - mm);
        const float inv = 1.f / (ls[0] * fa + lB * fb);
        const float ia = fa * inv, ib = fb * inv;
#pragma unroll
        for (int r = 0; r < 16; ++r) { oa0[r] = oa0[r] * ia + mb[2 + r] * ib; oa1[r] = oa1[r] * ia + mb[18 + r] * ib; }
        f32x16 oA[2] = {oa0, oa1};
        bf16_t* grow = Gp + (size_t)(wq * 32 + r32) * 1024 + 4 * hi;
#pragma unroll
        for (int dh = 0; dh < 2; ++dh)
#pragma unroll
            for (int g = 0; g < 4; ++g) {
                const u32x2 gg = *(const u32x2*)(grow + 32 * dh + 8 * g);
                const float a = oA[dh][4 * g] * bf_lo(gg.x), b = oA[dh][4 * g + 1] * bf_hi(gg.x);
                const float c = oA[dh][4 * g + 2] * bf_lo(gg.y), d = oA[dh][4 * g + 3] * bf_hi(gg.y);
                u32x2 w; w.x = cvtpk(a, b); w.y = cvtpk(c, d); if (!dry) *(u32x2*)(grow + 32 * dh + 8 * g) = w; }
    }
    __syncthreads();
}
}
#undef LAS
#define LAS __attribute__((address_space(3)))
typedef unsigned short bf16_t;
typedef float f32x4 __attribute__((ext_vector_type(4)));
typedef unsigned u32x4 __attribute__((ext_vector_type(4)));
typedef unsigned u32x2 __attribute__((ext_vector_type(2)));
constexpr int NB = 4, SEQ = 4096, DM = 1024, DEPTH = 4, DIN = 3072, NMEM = 256, MROWS = NB * SEQ;
constexpr int LDS_BYTES = 147456;
constexpr size_t MiB = 1u << 20;
constexpr size_t WS_WIN = 0;
constexpr size_t WS_WOUT = 24 * MiB;
constexpr size_t WS_WMEM = 32 * MiB;
constexpr size_t WS_XB = 36 * MiB;
constexpr size_t WS_MEMB = 68 * MiB;
constexpr size_t WS_QK = 70 * MiB;
constexpr size_t WS_VT = 118 * MiB;
constexpr size_t WS_KM = 134 * MiB;
constexpr size_t WS_VM = 136 * MiB;
constexpr size_t WS_G = 138 * MiB;
constexpr size_t WS_Y = 170 * MiB;
constexpr size_t WS_SSQ = 202 * MiB;
constexpr size_t WS_ROPE = 203 * MiB;
constexpr size_t WS_RSX = 204 * MiB;
constexpr size_t WS_RSM = 204 * MiB + 65536;
constexpr size_t WS_LAM = 204 * MiB + 131072;
constexpr size_t WS_BAR = 204 * MiB + 524288;
constexpr size_t WS_END = 205 * MiB;

DI float wave_sum(float v) {
#pragma unroll
    for (int o = 1; o < 64; o <<= 1) v += __shfl_xor(v, o);
    return v;
}
DI void transpose_item(const float* __restrict__ W, int K, int N, const float* __restrict__ gk, bf16_t* __restrict__ WT, bool headperm, LAS float* scr, int item, int lane) {
    const int nblk = N / 32, kb = item / nblk, nb = item % nblk, k0 = 64 * kb, n0 = 32 * nb;
    float wv[32];
#pragma unroll
    for (int i = 0; i < 32; ++i) wv[i] = W[(size_t)(k0 + 2 * i + (lane >> 5)) * N + n0 + (lane & 31)];
#pragma unroll
    for (int i = 0; i < 32; ++i) { const int kk = 2 * i + (lane >> 5); float w = wv[i]; if (gk) w *= gk[k0 + kk]; scr[kk * 33 + (lane & 31)] = w; }
    asm volatile("s_waitcnt lgkmcnt(0)" ::: "memory");
    int drow0 = n0; if (headperm) { const int w = n0 & 255; drow0 = (n0 & ~255) + 128 * ((w & 63) >> 5) + 32 * (w >> 6); }
    const int c = lane & 7;
#pragma unroll
    for (int j = 0; j < 4; ++j) { const int n = (lane >> 3) + 8 * j; const LAS float* s = scr + (8 * c) * 33 + n;
        u32x4 o; o.x = cvtpk(s[0 * 33], s[1 * 33]); o.y = cvtpk(s[2 * 33], s[3 * 33]); o.z = cvtpk(s[4 * 33], s[5 * 33]); o.w = cvtpk(s[6 * 33], s[7 * 33]);
        *(u32x4*)(WT + (size_t)(drow0 + n) * K + k0 + 8 * c) = o; }
    asm volatile("s_waitcnt lgkmcnt(0)" ::: "memory");
}
DI void row_update(const float* __restrict__ xin, const bf16_t* __restrict__ y, const float* __restrict__ ssq, const float* __restrict__ gpost, float* xout, bf16_t* xb, float* rs_out, int lane) {
    f32x4 v[4];
    if (xin) {
#pragma unroll
        for (int j = 0; j < 4; ++j) v[j] = *(const f32x4*)(xin + 4 * lane + 256 * j);
    } else {
#pragma unroll
        for (int j = 0; j < 4; ++j) { const u32x2 xx = *(const u32x2*)(xb + 4 * lane + 256 * j); v[j][0] = bf_lo(xx.x); v[j][1] = bf_hi(xx.x); v[j][2] = bf_lo(xx.y); v[j][3] = bf_hi(xx.y); }
    }
    if (y) {
        float sy = 0.f;
#pragma unroll
        for (int i = 0; i < 4; ++i) { const f32x4 q = *(const f32x4*)(ssq + 4 * i); sy += (q[0] + q[1]) + (q[2] + q[3]); }
        const float ry = rsqrtf(sy * (1.f / 1024.f) + NORM_EPS);
#pragma unroll
        for (int j = 0; j < 4; ++j) { const u32x2 yy = *(const u32x2*)(y + 4 * lane + 256 * j); const f32x4 g = *(const f32x4*)(gpost + 4 * lane + 256 * j);
            v[j][0] += bf_lo(yy.x) * ry * g[0]; v[j][1] += bf_hi(yy.x) * ry * g[1]; v[j][2] += bf_lo(yy.y) * ry * g[2]; v[j][3] += bf_hi(yy.y) * ry * g[3]; }
    }
    float s = 0.f;
#pragma unroll
    for (int j = 0; j < 4; ++j) s += (v[j][0] * v[j][0] + v[j][1] * v[j][1]) + (v[j][2] * v[j][2] + v[j][3] * v[j][3]);
    s = wave_sum(s);
    if (xout) {
#pragma unroll
        for (int j = 0; j < 4; ++j) *(f32x4*)(xout + 4 * lane + 256 * j) = v[j];
    } else {
#pragma unroll
        for (int j = 0; j < 4; ++j) { u32x2 w; w.x = cvtpk(v[j][0], v[j][1]); w.y = cvtpk(v[j][2], v[j][3]); *(u32x2*)(xb + 4 * lane + 256 * j) = w; }
        if (lane == 0) *rs_out = rsqrtf(s * (1.f / 1024.f) + NORM_EPS);
    }
}
template <int R>
DI void rows_update(const float* __restrict__ xin, const bf16_t* __restrict__ y, const float* __restrict__ ssq, const float* __restrict__ gpost, float* xout, bf16_t* xb, float* rs_out, int m0, int mstep, int lane) {
    f32x4 v[R][4]; u32x2 yy[R][4]; f32x4 q[R][4];
#pragma unroll
    for (int r = 0; r < R; ++r) { const size_t m = m0 + r * mstep;
        if (xin) {
#pragma unroll
            for (int j = 0; j < 4; ++j) v[r][j] = *(const f32x4*)(xin + m * DM + 4 * lane + 256 * j);
        } else {
#pragma unroll
            for (int j = 0; j < 4; ++j) { const u32x2 xx = *(const u32x2*)(xb + m * DM + 4 * lane + 256 * j); v[r][j][0] = bf_lo(xx.x); v[r][j][1] = bf_hi(xx.x); v[r][j][2] = bf_lo(xx.y); v[r][j][3] = bf_hi(xx.y); }
        }
        if (y) {
#pragma unroll
            for (int j = 0; j < 4; ++j) { yy[r][j] = *(const u32x2*)(y + m * DM + 4 * lane + 256 * j); q[r][j] = *(const f32x4*)(ssq + m * 16 + 4 * j); }
        }
    }
    if (y) {
#pragma unroll
        for (int r = 0; r < R; ++r) {
            float sy = 0.f;
#pragma unroll
            for (int i = 0; i < 4; ++i) sy += (q[r][i][0] + q[r][i][1]) + (q[r][i][2] + q[r][i][3]);
            const float ry = rsqrtf(sy * (1.f / 1024.f) + NORM_EPS);
#pragma unroll
            for (int j = 0; j < 4; ++j) { const f32x4 g = *(const f32x4*)(gpost + 4 * lane + 256 * j);
                v[r][j][0] += bf_lo(yy[r][j].x) * ry * g[0]; v[r][j][1] += bf_hi(yy[r][j].x) * ry * g[1]; v[r][j][2] += bf_lo(yy[r][j].y) * ry * g[2]; v[r][j][3] += bf_hi(yy[r][j].y) * ry * g[3]; }
        }
    }
#pragma unroll
    for (int r = 0; r < R; ++r) { const size_t m = m0 + r * mstep;
        float s = 0.f;
#pragma unroll
        for (int j = 0; j < 4; ++j) s += (v[r][j][0] * v[r][j][0] + v[r][j][1] * v[r][j][1]) + (v[r][j][2] * v[r][j][2] + v[r][j][3] * v[r][j][3]);
        s = wave_sum(s);
        if (xout) {
#pragma unroll
            for (int j = 0; j < 4; ++j) *(f32x4*)(xout + m * DM + 4 * lane + 256 * j) = v[r][j];
        } else {
#pragma unroll
            for (int j = 0; j < 4; ++j) { u32x2 w; w.x = cvtpk(v[r][j][0], v[r][j][1]); w.y = cvtpk(v[r][j][2], v[r][j][3]); *(u32x2*)(xb + m * DM + 4 * lane + 256 * j) = w; }
            if (lane == 0) rs_out[m] = rsqrtf(s * (1.f / 1024.f) + NORM_EPS);
        }
    }
}
DI void rope_entry(int idx, float2* out) {
    const int pos = idx >> 4, j = idx & 15;
    const int jl = j & 3, jh = j >> 2;
    const double ml = jl == 0 ? 1.0 : (jl == 1 ? 0.5623413251903491 : (jl == 2 ? 0.31622776601683794 : 0.1778279410038923));
    const double mh = jh == 0 ? 1.0 : (jh == 1 ? 0.1 : (jh == 2 ? 0.01 : 0.001));
    const float inv = (float)(ml * mh);
    const float angf = (float)pos * inv;
    const double a = (double)angf;
    const double kq = __builtin_rint(a * 0.63661977236758134308);
    double r = __builtin_fma(-kq, 1.57079632679489655800e+00, a); r = __builtin_fma(-kq, 6.12323399573676603587e-17, r);
    const int q = ((int)kq) & 3;
    const double r2 = r * r;
    const double sn = r * (1.0 + r2 * (-1.0 / 6 + r2 * (1.0 / 120 + r2 * (-1.0 / 5040 + r2 * (1.0 / 362880 + r2 * (-1.0 / 39916800 + r2 * (1.0 / 6227020800.0)))))));
    const double cs = 1.0 + r2 * (-0.5 + r2 * (1.0 / 24 + r2 * (-1.0 / 720 + r2 * (1.0 / 40320 + r2 * (-1.0 / 3628800 + r2 * (1.0 / 479001600.0 + r2 * (-1.0 / 87178291200.0)))))));
    const double c = q == 0 ? cs : (q == 1 ? -sn : (q == 2 ? -cs : sn));
    const double s = q == 0 ? sn : (q == 1 ? cs : (q == 2 ? -sn : -cs));
    *out = make_float2((float)c, (float)s);
}

#ifndef PROBE_REP
#define PROBE_REP 0
#endif
#ifndef PROBE_VAR
#define PROBE_VAR 0
#endif
#ifndef GQA_SPLIT
#define GQA_SPLIT 0
#endif
#ifndef SCHED_XCDHALF
#define SCHED_XCDHALF 1
#endif
#if PROBE_VAR == 2
#define ATT_CALL(D, ...) do { if (rep == 0) att::attn_unit<D, true>(__VA_ARGS__); else att::attn_unit<D, false>(__VA_ARGS__); } while (0)
#else
#define ATT_CALL(D, ...) do { if (!safe_pass) { if (att::attn_unit<D, false, true>(__VA_ARGS__)) redo |= 1u << unit_no; } else if ((redo >> unit_no) & 1u) att::attn_unit<D, false, false>(__VA_ARGS__); ++unit_no; } while (0)
#endif
#define XB_TMO      128
#define XB_XCNT(j)  (256  + 64 * (j))
#define XB_XSUB(j)  (1280 + 64 * (j))
#define XB_XGEN(j)  (2304 + 64 * (j))
#define XB_TOP      3328
#define XB_TOPGEN   3392
#define XCD_BAR_WORDS 3456
#define XB_SPIN_CAP (1u << 18)

__device__ __forceinline__ unsigned xb_ld(unsigned* p)              { return __hip_atomic_load(p, __ATOMIC_RELAXED, __HIP_MEMORY_SCOPE_AGENT); }
__device__ __forceinline__ unsigned xb_add(unsigned* p, unsigned v) { return __hip_atomic_fetch_add(p, v, __ATOMIC_RELAXED, __HIP_MEMORY_SCOPE_AGENT); }
__device__ __forceinline__ unsigned xb_xcc_id() { return (unsigned)__builtin_amdgcn_s_getreg((3 << 11) | 20) & 0xFu; }
#define XB_SPIN(cond, bar) do { unsigned _sp = 0; while (cond) { __builtin_amdgcn_s_sleep(1); \
    if ((++_sp & 255u) == 0u) { if (xb_ld(&(bar)[XB_TMO])) break; if (_sp > XB_SPIN_CAP) { atomicAdd(&(bar)[XB_TMO], 1u); break; } } } } while (0)

struct XcdBarrier {
    unsigned* bar; unsigned x;
    volatile LAS unsigned* st;
};

__device__ __forceinline__ XcdBarrier xcd_barrier_post(unsigned* bar, volatile LAS unsigned* st) {
    XcdBarrier b; b.bar = bar; b.x = xb_xcc_id(); b.st = st;
    if (threadIdx.x == 0) (void)xb_add(&bar[XB_XCNT(b.x)], 1u);
    return b;
}
__device__ __forceinline__ void xcd_barrier_complete(unsigned* bar, unsigned x, unsigned& nloc, unsigned& nx) {
    const unsigned G = gridDim.x * gridDim.y * gridDim.z;
    unsigned sum, cnt, mine, sp = 0u;
    for (;;) {
        sum = 0u; cnt = 0u; mine = 0u;
#pragma unroll
        for (unsigned j = 0; j < 16; ++j) { const unsigned c = xb_ld(&bar[XB_XCNT(j)]); sum += c; cnt += (c > 0u) ? 1u : 0u; mine = (j == x) ? c : mine; }
        if (sum == G) break;
        __builtin_amdgcn_s_sleep(1);
        if ((++sp & 255u) == 0u) { if (xb_ld(&bar[XB_TMO])) break; if (sp > XB_SPIN_CAP) { atomicAdd(&bar[XB_TMO], 1u); break; } }
    }
    nloc = mine > 0u ? mine : 1u; nx = cnt > 0u ? cnt : 1u;
}

__device__ __forceinline__ void xcd_barrier(const XcdBarrier& b, bool t0) {
    asm volatile("s_waitcnt vmcnt(0)" ::: "memory");
    __syncthreads();
    if (t0) {
        unsigned* bar = b.bar;
        __builtin_amdgcn_s_waitcnt(0);
        unsigned nloc = b.st[0], nx = b.st[1];
        if (nloc == 0u) { xcd_barrier_complete(bar, b.x, nloc, nx); b.st[0] = nloc; b.st[1] = nx; }
        const unsigned old = xb_add(&bar[XB_XSUB(b.x)], 1u);
        const unsigned gen = old / nloc;
        if (old + 1u == (gen + 1u) * nloc) {
            __builtin_amdgcn_fence(__ATOMIC_RELEASE, "agent");
            asm volatile("s_waitcnt vmcnt(0)" ::: "memory");
            const unsigned og = xb_add(&bar[XB_TOP], 1u);
            const unsigned tg = og / nx;
            if (og + 1u == (tg + 1u) * nx) xb_add(&bar[XB_TOPGEN], 1u);
            else XB_SPIN(xb_ld(&bar[XB_TOPGEN]) == tg, bar);
            __builtin_amdgcn_fence(__ATOMIC_ACQUIRE, "agent");
            xb_add(&bar[XB_XGEN(b.x)], 1u);
            asm volatile("s_waitcnt vmcnt(0)" ::: "memory");
        } else {
            XB_SPIN(xb_ld(&bar[XB_XGEN(b.x)]) == gen, bar);
            __builtin_amdgcn_fence(__ATOMIC_ACQUIRE, "agent");
            asm volatile("s_waitcnt vmcnt(0)" ::: "memory");
        }
    }
    __syncthreads();
}

struct Args { const float* in[12]; float* out; unsigned char* ws; int ph_lo, ph_hi; };
constexpr int N_PHASES = 1 + 4 * DEPTH;
constexpr int I_IN = 16 * 96, I_OUT = 16 * 32;

__global__ void __launch_bounds__(512, 2) fwd(Args a) {
    extern __shared__ __attribute__((aligned(16))) unsigned char lds_raw[];
    LAS unsigned char* lds = (LAS unsigned char*)lds_raw;
    cg::grid_group grid = cg::this_grid();
    const int wave_s = __builtin_amdgcn_readfirstlane(threadIdx.x >> 6);
    const int G = gridDim.x, bx = blockIdx.x;
    const int vcu = (G % 8 == 0) ? (bx % 8) * (G / 8) + bx / 8 : bx;
    const int lo = a.ph_lo, hi = a.ph_hi;
#define WS_PTRS() size_t wso_ = 0; asm volatile("" : "+s"(wso_)); unsigned char* ws = a.ws + wso_;     \
    const int lane = lane_now(), wave = wave_s, tid = (wave_s << 6) | lane; (void)lane; (void)wave; (void)tid; \
    bf16_t* WIN = (bf16_t*)(ws + WS_WIN); bf16_t* WOUT = (bf16_t*)(ws + WS_WOUT); bf16_t* WMEM = (bf16_t*)(ws + WS_WMEM); \
    bf16_t* XB = (bf16_t*)(ws + WS_XB); bf16_t* MEMB = (bf16_t*)(ws + WS_MEMB); bf16_t* QK = (bf16_t*)(ws + WS_QK); bf16_t* VT = (bf16_t*)(ws + WS_VT); \
    bf16_t* KM = (bf16_t*)(ws + WS_KM); bf16_t* VM = (bf16_t*)(ws + WS_VM); bf16_t* GB = (bf16_t*)(ws + WS_G); bf16_t* YB = (bf16_t*)(ws + WS_Y); \
    float* SSQ = (float*)(ws + WS_SSQ); float2* ROPE = (float2*)(ws + WS_ROPE); float* RSX = (float*)(ws + WS_RSX); float* RSM = (float*)(ws + WS_RSM); float* LAM = (float*)(ws + WS_LAM); \
    (void)WIN; (void)WOUT; (void)WMEM; (void)XB; (void)MEMB; (void)QK; (void)VT; (void)KM; (void)VM; (void)GB; (void)YB; (void)SSQ; (void)ROPE; (void)RSX; (void)RSM; (void)LAM;
#define RUN(k) (lo <= (k) && (k) < hi)
#if PROBE_REP == 4
#define SEAM(k) do { if (RUN(k) && RUN((k) + 1)) { xcd_barrier(xbar, wave_s == 0 && lane_now() == 0); xcd_barrier(xbar, wave_s == 0 && lane_now() == 0); } } while (0)
#else
#define SEAM(k) do { if (RUN(k) && RUN((k) + 1)) xcd_barrier(xbar, wave_s == 0 && lane_now() == 0); } while (0)
#endif

    if (threadIdx.x < 2) ((volatile LAS unsigned*)(lds + 131072 + 64))[threadIdx.x] = 0u;
    __syncthreads();
    if (RUN(0)) { WS_PTRS();
        if (bx == 0) for (int i = tid; i < XCD_BAR_WORDS; i += 512) __hip_atomic_store((unsigned*)(ws + WS_BAR) + i, 0u, __ATOMIC_RELAXED, __HIP_MEMORY_SCOPE_AGENT);
        if (bx == 0 && wave < DEPTH) {
            const float* lp = a.in[4] + wave * 128; const int li = lane & 31;
            const float p1 = lp[li] * lp[32 + li], p2 = lp[64 + li] * lp[96 + li];
            const float s1 = wave_sum(lane < 32 ? p1 : 0.f), s2 = wave_sum(lane < 32 ? p2 : 0.f);
            if (lane == 0) LAM[wave] = expf(s1) - expf(s2) + (0.8f - 0.6f * expf(-0.3f * (float)wave));
        }
        LAS float* scr = (LAS float*)(lds + wave * 16384);
        const int gw = vcu * 8 + wave, NGW = G * 8;
        constexpr int I_MEM = 16 * 16, NITEMS0 = DEPTH * I_MEM + I_IN + I_OUT;
#if PROBE_REP == 6
        for (int rep = 0; rep < 2; ++rep) {
#else
        {
#endif
        for (int it = gw; it < NITEMS0; it += NGW) {
            int r = it;
            if (r < DEPTH * I_MEM) { const int l = r / I_MEM; r -= l * I_MEM;
                transpose_item(a.in[9] + (size_t)l * DM * 512, DM, 512, a.in[8] + l * DM, WMEM + (size_t)l * 512 * DM, true, scr, r, lane); continue; }
            r -= DEPTH * I_MEM;
            if (r < I_IN) transpose_item(a.in[3], DM, DIN, a.in[2], WIN, true, scr, r, lane);
            else transpose_item(a.in[10], DM, DM, nullptr, WOUT, false, scr, r - I_IN, lane);
        }
        for (int m = gw; m < MROWS; m += 2 * NGW) rows_update<2>(a.in[0], nullptr, nullptr, nullptr, nullptr, XB, RSX, m, NGW, lane);
        for (int m = gw; m < NB * NMEM; m += NGW) row_update(a.in[1] + (size_t)m * DM, nullptr, nullptr, nullptr, nullptr, MEMB + (size_t)m * DM, RSM + m, lane);
        }
        for (int i = (vcu * 512 + tid); i < 4096 * 16; i += G * 512) rope_entry(i, ROPE + i);

    }
    XcdBarrier xbar; xbar.bar = (unsigned*)(a.ws + WS_BAR); xbar.x = 0; xbar.st = (volatile LAS unsigned*)(lds + 131072 + 64);
    if (RUN(0) && RUN(1)) { grid.sync(); xbar = xcd_barrier_post((unsigned*)(a.ws + WS_BAR), (volatile LAS unsigned*)(lds + 131072 + 64)); }

    for (int l = 0; l < DEPTH; ++l) {
        const int p0 = 1 + 4 * l;
        if (RUN(p0)) { WS_PTRS();
            { pg8::Gemm g{XB, WIN + (size_t)l * DIN * DM, MROWS, DIN, DM}; pg8::StaticOrder S; S.init(MROWS, DIN, G, bx);
              pg8::EpiIn E{RSX, QK, VT, GB, ROPE, a.in[6] + l * 64, a.in[7] + l * 64};
#if PROBE_REP == 1
              for (int rep = 0; rep < 2; ++rep)
#endif
              pg8::gemm_phase<pg8::EpiIn, pg8::StaticOrder, true, true>(lds, g, S, E, wave_s);
            }
            if (l == 0) { pg8::Gemm g{MEMB, WMEM, NB * NMEM, DEPTH * 512, DM}; pg8::StaticOrder S; S.init(NB * NMEM, DEPTH * 512, G, (bx + G - 32) % G);
              pg8::EpiMemKV E{RSM, KM, VM};
              pg8::gemm_phase<pg8::EpiMemKV, pg8::StaticOrder, true, true>(lds, g, S, E, wave_s); }
        }
        SEAM(p0);
        if (RUN(p0 + 1)) { WS_PTRS();
#if PROBE_REP == 2
            for (int rep = 0; rep < 2; ++rep)
#else
            const int rep = 1;
#endif
#if SCHED_XCDHALF
            unsigned redo = 0u;
            for (int safe_pass = 0; safe_pass < 2; ++safe_pass) { int unit_no = 0; if (safe_pass && !redo) break;
            for (int idx = vcu + 2 * G; idx >= 0; idx -= G) {
                if (idx < 384) { const int bh = idx >> 4, qb = idx & 15, b = bh / 6, h = bh % 6;
                    ATT_CALL(true, lds, QK + ((size_t)(b * 24 + h) * SEQ + qb * 256) * 64, QK + (size_t)(b * 24 + 6 + h) * SEQ * 64, VT + (size_t)(b * 8 + h) * 64 * SEQ, SEQ,
                                         GB + ((size_t)b * SEQ + qb * 256) * DM + h * 64, LAM + l, a.in[5] + l * 64, l, rep == 0, wave_s);
                } else { const int i = idx - 384, bh = i >> 4, qb = i & 15, b = bh / 6, h = bh % 6, kvh = h / 3;
                    ATT_CALL(false, lds, QK + ((size_t)(b * 24 + 12 + h) * SEQ + qb * 256) * 64, QK + (size_t)(b * 24 + 18 + kvh) * SEQ * 64, VT + (size_t)(b * 8 + 6 + kvh) * 64 * SEQ, SEQ,
                                          GB + ((size_t)b * SEQ + qb * 256) * DM + 384 + h * 64, nullptr, nullptr, l, rep == 0, wave_s);
                }
            }
            if (vcu >= 128) for (int k = 0; k < 2; ++k) { const int i = 2 * (vcu - 128) + k, bh = i >> 4, qb = i & 15, b = bh >> 2, h = bh & 3;
                ATT_CALL(false, lds, QK + ((size_t)(b * 24 + 20 + h) * SEQ + qb * 256) * 64, KM + (size_t)((l * 4 + b) * 4 + h) * NMEM * 64, VM + (size_t)((l * 4 + b) * 4 + h) * 64 * NMEM, NMEM,
                                      GB + ((size_t)b * SEQ + qb * 256) * DM + 768 + h * 64, nullptr, nullptr, l, rep == 0, wave_s); }
            }
            const bool light_wg = vcu >= 128; const int light_ix = vcu - 128;
#else
            {
                const int x = vcu >> 5, j = vcu & 31, heavy = j < 16;
                for (int k = 0; k < (heavy ? 2 : 1); ++k) {
                    const int du = heavy ? j + 16 * k : 32 + (j - 16), bh = 3 * x + (du >> 4), qb = du & 15, b = bh / 6, h = bh % 6;
                    ATT_CALL(true, lds, QK + ((size_t)(b * 24 + h) * SEQ + qb * 256) * 64, QK + (size_t)(b * 24 + 6 + h) * SEQ * 64, VT + (size_t)(b * 8 + h) * 64 * SEQ, SEQ,
                                         GB + ((size_t)b * SEQ + qb * 256) * DM + h * 64, LAM + l, a.in[5] + l * 64, l, rep == 0, wave_s);
                }
#if GQA_SPLIT
                { const int b = x >> 1, kvh = x & 1, ng = heavy ? 1 : 5, g0 = heavy ? j : 16 + 5 * (j - 16);
                  for (int k = 0; k < ng; ++k) { const int gu = g0 + k, h = kvh * 3 + (gu >> 5), q128 = gu & 31;
                    att::attn_unit_split(lds, QK + ((size_t)(b * 24 + 12 + h) * SEQ + q128 * 128) * 64, QK + (size_t)(b * 24 + 18 + kvh) * SEQ * 64, VT + (size_t)(b * 8 + 6 + kvh) * 64 * SEQ, SEQ,
                                         GB + ((size_t)b * SEQ + q128 * 128) * DM + 384 + h * 64, rep == 0, wave_s); } }
#else
                { const int b = x >> 1, kvh = x & 1, ng = heavy ? 1 : 2, g0 = heavy ? j : 16 + 2 * (j - 16);
                  for (int k = 0; k < ng; ++k) { const int gu = g0 + k, h = kvh * 3 + (gu >> 4), qb = gu & 15;
                    ATT_CALL(false, lds, QK + ((size_t)(b * 24 + 12 + h) * SEQ + qb * 256) * 64, QK + (size_t)(b * 24 + 18 + kvh) * SEQ * 64, VT + (size_t)(b * 8 + 6 + kvh) * 64 * SEQ, SEQ,
                                         GB + ((size_t)b * SEQ + qb * 256) * DM + 384 + h * 64, nullptr, nullptr, l, rep == 0, wave_s); } }
#endif
                if (GQA_SPLIT ? heavy : !heavy) for (int k = 0; k < 2; ++k) { const int i = x * 32 + 2 * (j & 15) + k, bh = i >> 4, qb = i & 15, b = bh >> 2, h = bh & 3;
                    ATT_CALL(false, lds, QK + ((size_t)(b * 24 + 20 + h) * SEQ + qb * 256) * 64, KM + (size_t)((l * 4 + b) * 4 + h) * NMEM * 64, VM + (size_t)((l * 4 + b) * 4 + h) * 64 * NMEM, NMEM,
                                          GB + ((size_t)b * SEQ + qb * 256) * DM + 768 + h * 64, nullptr, nullptr, l, rep == 0, wave_s); }
            }
            const bool light_wg = (vcu & 31) >= 16; const int light_ix = (vcu >> 5) * 16 + ((vcu & 31) - 16);
#endif
            if (l + 1 < DEPTH && light_wg) {
                __syncthreads();
                LAS float* scr = (LAS float*)(lds + wave * 16384);
                const int lw_ = light_ix * 8 + wave;
                for (int it = lw_; it < I_IN + I_OUT; it += 1024) {
                    if (it < I_IN) transpose_item(a.in[3] + (size_t)(l + 1) * DM * DIN, DM, DIN, a.in[2] + (l + 1) * DM, WIN + (size_t)(l + 1) * DIN * DM, true, scr, it, lane);
                    else transpose_item(a.in[10] + (size_t)(l + 1) * DM * DM, DM, DM, nullptr, WOUT + (size_t)(l + 1) * DM * DM, false, scr, it - I_IN, lane);
                }
            }
        }
        SEAM(p0 + 1);
        if (RUN(p0 + 2)) { WS_PTRS();
            pg8::Gemm g{GB, WOUT + (size_t)l * DM * DM, MROWS, DM, DM}; pg8::StaticOrder S; S.init(MROWS, DM, G, bx);
            pg8::EpiOut E{YB, SSQ};
            pg8::gemm_phase<pg8::EpiOut, pg8::StaticOrder, true, true>(lds, g, S, E, wave_s);
#if PROBE_REP == 3
            pg8::gemm_phase<pg8::EpiOut, pg8::StaticOrder, true, true>(lds, g, S, E, wave_s);
#endif
        }
        SEAM(p0 + 2);
        if (RUN(p0 + 3)) { WS_PTRS();
            const int gw = vcu * 8 + wave, NGW = G * 8;
#if PROBE_REP == 5
            for (int m = gw; m < MROWS; m += NGW)
                row_update(l == 0 ? a.in[0] + (size_t)m * DM : nullptr, YB + (size_t)m * DM, SSQ + (size_t)m * 16, a.in[11] + l * DM, (float*)(ws + WS_QK) + (size_t)m * DM, XB + (size_t)m * DM, (float*)(ws + WS_RSX + 262144) + m, lane);
#endif
            for (int m = gw; m < MROWS; m += 2 * NGW)
                rows_update<2>(l == 0 ? a.in[0] : nullptr, YB, SSQ, a.in[11] + l * DM, l == DEPTH - 1 ? a.out : nullptr, XB, RSX, m, NGW, lane);
        }
        SEAM(p0 + 3);
    }
}

extern "C" void kernel_launch(void* const* d_in, const int* in_sizes, int n_in, void* d_out, int out_size, void* d_ws, size_t ws_size, hipStream_t stream) {
    static int grid = 0;
    if (grid == 0) {
        if (n_in != 12 || ws_size < WS_END) { fprintf(stderr, "kernel_launch: unexpected problem (n_in %d, ws %zu)\n", n_in, ws_size); grid = -1; return; }
        int dev = 0, cus = 0, per_cu = 0;
        hipGetDevice(&dev); hipDeviceGetAttribute(&cus, hipDeviceAttributeMultiprocessorCount, dev);
        if (hipFuncSetAttribute((const void*)fwd, hipFuncAttributeMaxDynamicSharedMemorySize, LDS_BYTES) != hipSuccess) { fprintf(stderr, "kernel_launch: hipFuncSetAttribute failed\n"); grid = -1; return; }
        if (hipOccupancyMaxActiveBlocksPerMultiprocessor(&per_cu, (const void*)fwd, 512, LDS_BYTES) != hipSuccess || per_cu < 1) { fprintf(stderr, "kernel_launch: occupancy query says %d blocks per CU\n", per_cu); per_cu = 1; }
        (void)hipGetLastError();
        grid = 256;
        if (cus < 256) fprintf(stderr, "kernel_launch: %d CUs < 256: the cooperative launch will be refused\n", cus);
    }
    if (grid < 0) return;
    Args a{};
    for (int i = 0; i < 12; ++i) a.in[i] = (const float*)d_in[i];
    a.out = (float*)d_out; a.ws = (unsigned char*)d_ws;
#if ONE_LAUNCH
    a.ph_lo = 0; a.ph_hi = N_PHASES;
    void* args[] = {&a};
    hipError_t e = hipLaunchCooperativeKernel((const void*)fwd, dim3(grid), dim3(512), args, LDS_BYTES, stream);
    if (e != hipSuccess) fprintf(stderr, "kernel_launch: cooperative launch failed: %s (grid %d)\n", hipGetErrorString(e), grid);
#else
    for (int k = 0; k < N_PHASES; ++k) { a.ph_lo = k; a.ph_hi = k + 1; hipLaunchKernelGGL(fwd, dim3(grid), dim3(512), LDS_BYTES, stream, a); }
#endif
}
```

```cpp
#include <hip/hip_runtime.h>
#include <hip/hip_cooperative_groups.h>
#include <cstdio>
#include <cstdint>
namespace cg = cooperative_groups;
#ifndef ONE_LAUNCH
#define ONE_LAUNCH 1
#endif
#define DI __device__ __forceinline__
typedef float f32x2_t __attribute__((ext_vector_type(2)));
typedef __bf16 bf16x2_t __attribute__((ext_vector_type(2)));
DI unsigned cvtpk(float lo, float hi) { f32x2_t v = {lo, hi}; bf16x2_t b = __builtin_convertvector(v, bf16x2_t); return __builtin_bit_cast(unsigned, b); }
DI float bf_lo(unsigned u) { return __uint_as_float(u << 16); }
DI float bf_hi(unsigned u) { return __uint_as_float(u & 0xffff0000u); }
constexpr float NORM_EPS = 1e-6f;
constexpr float LOG2E = 1.4426950408889634f;
constexpr float SC_D = 0.17677669529663687f * LOG2E;
constexpr float SC_G = 0.125f * LOG2E;
DI int vpos(int t) { const int k = t & 15; return (t & ~15) | (((k >> 2) & 1) << 3) | ((k >> 3) << 2) | (k & 3); }
DI int lane_now() { int l; asm volatile("v_mbcnt_lo_u32_b32 %0, -1, 0\n\tv_mbcnt_hi_u32_b32 %0, -1, %0" : "=v"(l)); return l; }
typedef float f32x4 __attribute__((ext_vector_type(4)));
namespace pg8 {
#define PG8_LAS __attribute__((address_space(3)))
typedef unsigned short bf16_t;
typedef short bf16x8 __attribute__((ext_vector_type(8)));
typedef float f32x4 __attribute__((ext_vector_type(4)));
typedef unsigned u32x4 __attribute__((ext_vector_type(4)));
constexpr int BM = 256, BK = 64, HALF = 128, HTB = HALF * BK * 2  , STAGE_BYTES = 8 * HTB, NXCD = 8, WGM = 8;

__host__ __device__ __forceinline__ int lds_byte(int r, int c) { const int st = (r >> 4) * 2 + (c >> 5), rr = r & 15, cc = c & 31, ob = rr * 64 + cc * 2; return st * 1024 + (ob ^ (((ob >> 9) & 1) << 5)); }
__host__ __device__ __forceinline__ void stage_rc(int b, int& R, int& C) { const int st = b / 1024, sb = b % 1024, swz = sb ^ (((sb >> 9) & 1) << 5); R = (st >> 1) * 16 + swz / 64; C = (st & 1) * 32 + (swz % 64) / 2; }
__host__ __device__ __forceinline__ int perm32(int rho) { const int n = rho >> 4, i = rho & 15; return 8 * (i >> 2) + 4 * n + (i & 3); }

struct Unit { int pm, pn; };
struct Gemm { const bf16_t* A; const bf16_t* Bt; int M, N, K; };

struct StaticOrder {
    int nM, nN, nwg, G, c;
    __host__ __device__ void init(int M, int N, int G_, int c_) { nM = M / BM; nN = N / BM; nwg = nM * nN; G = G_; c = c_; }
    __host__ __device__ bool next(int i, Unit& u) const {
        const long L = (long)i * G + c; if (L >= nwg) return false;
        int wgid = (int)L; { const int q = nwg / NXCD, r = nwg % NXCD, xcd = wgid % NXCD, off = wgid / NXCD; wgid = (xcd < r ? xcd * (q + 1) : r * (q + 1) + (xcd - r) * q) + off; }
        const int nig = WGM * nN, gid = wgid / nig, fm = gid * WGM, gsz = (nM - fm) < WGM ? (nM - fm) : WGM;
        u.pm = fm + ((wgid % nig) % gsz); u.pn = (wgid % nig) / gsz; return true;
    }
    __device__ __forceinline__ void a_ready(const Unit&) const {}
    __device__ __forceinline__ void done(const Unit&) const {}
};

typedef float2 rope_t;
DI void rope8(float (&v)[8], const rope_t* cs, int fq, float sc) {
    const f32x4 c0 = *(const f32x4*)(cs), c1 = *(const f32x4*)(cs + 2), c2 = *(const f32x4*)(cs + 4), c3 = *(const f32x4*)(cs + 6);
    const float cc[8] = {c0[0], c0[2], c1[0], c1[2], c2[0], c2[2], c3[0], c3[2]}, ss[8] = {c0[1], c0[3], c1[1], c1[3], c2[1], c2[3], c3[1], c3[3]};
#pragma unroll
    for (int j = 0; j < 8; ++j) { auto rr = __builtin_amdgcn_permlane32_swap(__float_as_uint(v[j]), __float_as_uint(v[j]), false, false);
        const float p = __uint_as_float(fq < 2 ? rr[1] : rr[0]); const float sp = fq < 2 ? -p : p; v[j] = (v[j] * cc[j] + sp * ss[j]) * sc; }
}
DI void store8(bf16_t* p, const float (&v)[8]) { u32x4 w; w.x = cvtpk(v[0], v[1]); w.y = cvtpk(v[2], v[3]); w.z = cvtpk(v[4], v[5]); w.w = cvtpk(v[6], v[7]); *(u32x4*)p = w; }
DI float silu(float x) { return x * __builtin_amdgcn_rcpf(1.f + __expf(-x)); }

struct EpiIn {
    static constexpr bool PERM = true, AFTER_DRAIN = false;
    const float* rs; bf16_t* QK; bf16_t* VT; bf16_t* G; const rope_t* rope; const float* gqn; const float* gkn;
    DI void operator()(const f32x4 (&acc)[2][2][4][2], const Unit& u, int wr, int wc, int fr, int fq) const {
        const int g64 = u.pn * 4 + wc;
#pragma unroll
        for (int ai = 0; ai < 2; ++ai)
#pragma unroll
            for (int m = 0; m < 4; ++m) {
                const int row = u.pm * BM + ai * HALF + wr * 64 + m * 16 + fr, b = row >> 12, t = row & 4095;
                const float rsv = rs[row];
                float v[2][8];
#pragma unroll
                for (int bj = 0; bj < 2; ++bj)
#pragma unroll
                    for (int n = 0; n < 2; ++n)
#pragma unroll
                        for (int i = 0; i < 4; ++i) v[bj][4 * n + i] = acc[ai][bj][m][n][i] * rsv;
                if (g64 < 12) {
                    const float sc = g64 < 6 ? SC_D : 1.f;
                    const rope_t* cs = rope + t * 16 + 8 * (fq & 1);
                    bf16_t* dst = QK + ((size_t)(b * 24 + g64) * 4096 + t) * 64 + 8 * fq;
#pragma unroll
                    for (int bj = 0; bj < 2; ++bj) { rope8(v[bj], cs, fq, sc); store8(dst + 32 * bj, v[bj]); }
                } else if (g64 < 18 || (g64 >= 32 && g64 < 34)) {
                    const int hv = g64 < 18 ? g64 - 12 : g64 - 32 + 6;
                    const bool odd = fr & 1;
                    bf16_t* dst = VT + ((size_t)(b * 8 + hv) * 64 + 8 * fq) * 4096 + vpos(t & ~1);
#pragma unroll
                    for (int bj = 0; bj < 2; ++bj)
#pragma unroll
                        for (int j2 = 0; j2 < 4; ++j2) {
                            const float mine = odd ? v[bj][2 * j2 + 1] : v[bj][2 * j2], send = odd ? v[bj][2 * j2] : v[bj][2 * j2 + 1];
                            const float got = __uint_as_float((unsigned)__builtin_amdgcn_update_dpp(0, (int)__float_as_uint(send), 0xB1, 0xF, 0xF, false));
                            const unsigned w = odd ? cvtpk(got, mine) : cvtpk(mine, got);
                            *(unsigned*)(dst + (size_t)(32 * bj + 2 * j2 + (odd ? 1 : 0)) * 4096) = w; }
                } else if (g64 < 24 || (g64 >= 34 && g64 < 40) || g64 >= 44) {
                    const int col = g64 < 24 ? (g64 - 18) * 64 : (g64 < 40 ? 384 + (g64 - 34) * 64 : 768 + (g64 - 44) * 64);
                    bf16_t* dst = G + (size_t)row * 1024 + col + 8 * fq;
#pragma unroll
                    for (int bj = 0; bj < 2; ++bj) {
#pragma unroll
                        for (int j = 0; j < 8; ++j) v[bj][j] = silu(v[bj][j]);
                        store8(dst + 32 * bj, v[bj]); }
                } else if (g64 < 32) {
                    float ss = 0.f;
#pragma unroll
                    for (int bj = 0; bj < 2; ++bj)
#pragma unroll
                        for (int j = 0; j < 8; ++j) ss += v[bj][j] * v[bj][j];
                    ss += __shfl_xor(ss, 16); ss += __shfl_xor(ss, 32);
                    const float r = rsqrtf(ss * (1.f / 64.f) + NORM_EPS);
                    const bool isq = g64 < 30; const float* gw = (isq ? gqn : gkn) + 8 * fq;
                    const int slot = isq ? 12 + (g64 - 24) : 18 + (g64 - 30);
                    bf16_t* dst = QK + ((size_t)(b * 24 + slot) * 4096 + t) * 64 + 8 * fq;
#pragma unroll
                    for (int bj = 0; bj < 2; ++bj) {
#pragma unroll
                        for (int j = 0; j < 8; ++j) v[bj][j] *= r * gw[32 * bj + j];
                        const int pos = bj == 0 ? (t >> 6) : (t & 63);
                        rope8(v[bj], rope + pos * 16 + 8 * (fq & 1), fq, isq ? SC_G : 1.f);
                        store8(dst + 32 * bj, v[bj]); }
                } else {
                    bf16_t* dst = QK + ((size_t)(b * 24 + 20 + (g64 - 40)) * 4096 + t) * 64 + 8 * fq;
#pragma unroll
                    for (int bj = 0; bj < 2; ++bj) {
#pragma unroll
                        for (int j = 0; j < 8; ++j) v[bj][j] *= SC_G;
                        store8(dst + 32 * bj, v[bj]); }
                }
                if (m == 3) asm volatile("" ::: "memory");
            }
    }
};

struct EpiMemKV {
    static constexpr bool PERM = true, AFTER_DRAIN = false;
    const float* rs; bf16_t* KM; bf16_t* VM;
    DI void operator()(const f32x4 (&acc)[2][2][4][2], const Unit& u, int wr, int wc, int fr, int fq) const {
        const int l = u.pn >> 1, isv = u.pn & 1;
#pragma unroll
        for (int ai = 0; ai < 2; ++ai)
#pragma unroll
            for (int m = 0; m < 4; ++m) {
                const int row = u.pm * BM + ai * HALF + wr * 64 + m * 16 + fr, b = row >> 8, t = row & 255;
                const float rsv = rs[row];
                float v[2][8];
#pragma unroll
                for (int bj = 0; bj < 2; ++bj)
#pragma unroll
                    for (int n = 0; n < 2; ++n)
#pragma unroll
                        for (int i = 0; i < 4; ++i) v[bj][4 * n + i] = acc[ai][bj][m][n][i] * rsv;
                const size_t hb = (size_t)((l * 4 + b) * 4 + wc);
                if (!isv) { bf16_t* dst = KM + (hb * 256 + t) * 64 + 8 * fq;
#pragma unroll
                    for (int bj = 0; bj < 2; ++bj) store8(dst + 32 * bj, v[bj]);
                } else { bf16_t* dst = VM + (hb * 64 + 8 * fq) * 256 + vpos(t);
#pragma unroll
                    for (int bj = 0; bj < 2; ++bj)
#pragma unroll
                        for (int j = 0; j < 8; ++j) dst[(size_t)(32 * bj + j) * 256] = (bf16_t)(cvtpk(v[bj][j], 0.f) & 0xffffu); }
                asm volatile("" ::: "memory");
            }
    }
};

struct EpiOut {
    static constexpr bool PERM = true, AFTER_DRAIN = false;
    bf16_t* Y; float* ssq;
    DI void operator()(const f32x4 (&acc)[2][2][4][2], const Unit& u, int wr, int wc, int fr, int fq) const {
#pragma unroll
        for (int ai = 0; ai < 2; ++ai)
#pragma unroll
            for (int m = 0; m < 4; ++m) {
                const int row = u.pm * BM + ai * HALF + wr * 64 + m * 16 + fr;
                float v[2][8]; float ss = 0.f;
#pragma unroll
                for (int bj = 0; bj < 2; ++bj)
#pragma unroll
                    for (int n = 0; n < 2; ++n)
#pragma unroll
                        for (int i = 0; i < 4; ++i) { const float x = acc[ai][bj][m][n][i]; v[bj][4 * n + i] = x; ss += x * x; }
                ss += __shfl_xor(ss, 16); ss += __shfl_xor(ss, 32);
                if (fq == 0) ssq[(size_t)row * 16 + u.pn * 4 + wc] = ss;
                bf16_t* dst = Y + (size_t)row * 1024 + u.pn * BM + wc * 32 + 8 * fq;
#pragma unroll
                for (int bj = 0; bj < 2; ++bj) store8(dst + bj * HALF, v[bj]);
                asm volatile("" ::: "memory");
            }
    }
};

template <class Epi, class Sched, bool ALIGN_EPI = false, bool SP2 = false>
__device__ __forceinline__ void gemm_phase(PG8_LAS unsigned char* lds, const Gemm g, const Sched& S, const Epi& E, int wave_s) {
    const int tid_ = (wave_s << 6) | lane_now();
    const int tid = tid_, wid = __builtin_amdgcn_readfirstlane(tid >> 6), lane = tid & 63, wr = wid >> 2, wc = wid & 3, fr = lane & 15, fq = lane >> 4;
    const int K = g.K, nt = K / BK;
    unsigned voffA[2], voffB[2];
#pragma unroll
    for (int i = 0; i < 2; ++i) { int R, C; stage_rc(tid * 16 + i * 8192, R, C); const int Rb = Epi::PERM ? ((R & ~31) + perm32(R & 31)) : R;
        voffA[i] = (unsigned)(R * K + C) * 2u; voffB[i] = (unsigned)(Rb * K + C) * 2u; }
    const size_t kstep = (size_t)(BK * 2);
    const size_t hstep = (size_t)HALF * K * 2;
    const size_t tstep = 2 * hstep;
    const unsigned ldsw = (unsigned)wid * 1024u;
    const int aoff = lds_byte(wr * 64 + fr, fq * 8), boff = lds_byte(wc * 32 + fr, fq * 8);
#define PG8_SA(b, h) (((b) * 2 + (h)) * HTB)
#define PG8_SB(b, h) ((4 + (b) * 2 + (h)) * HTB)
#define PG8_STAGE(bufoff, gbase, voff) do { _Pragma("unroll") for (int _i = 0; _i < 2; ++_i) \
        __builtin_amdgcn_global_load_lds((const unsigned*)((const char*)(gbase) + (voff)[_i]), (PG8_LAS unsigned*)(lds + (bufoff) + ldsw + _i * 8192), 16, 0, 0); } while (0)
#define PG8_LDA(dst, b, h) do { _Pragma("unroll") for (int m = 0; m < 4; ++m) _Pragma("unroll") for (int k = 0; k < 2; ++k) dst[m][k] = *(const PG8_LAS bf16x8*)(lds + PG8_SA(b, h) + aoff + m * 2048 + k * 1024); } while (0)
#define PG8_LDB(dst, b, h) do { _Pragma("unroll") for (int n = 0; n < 2; ++n) _Pragma("unroll") for (int k = 0; k < 2; ++k) dst[n][k] = *(const PG8_LAS bf16x8*)(lds + PG8_SB(b, h) + boff + n * 2048 + k * 1024); } while (0)
#define PG8_MMA(ai, bj, At, Bt) do { __builtin_amdgcn_s_setprio(1); _Pragma("unroll") for (int m = 0; m < 4; ++m) _Pragma("unroll") for (int n = 0; n < 2; ++n) _Pragma("unroll") for (int k = 0; k < 2; ++k) \
        acc[ai][bj][m][n] = __builtin_amdgcn_mfma_f32_16x16x32_bf16(Bt[n][k], At[m][k], acc[ai][bj][m][n], 0, 0, 0); __builtin_amdgcn_s_setprio(0); } while (0)
#define PG8_WAIT_V(n) asm volatile("s_waitcnt vmcnt(" #n ")" ::: "memory")
#define PG8_WAIT_L(n) asm volatile("s_waitcnt lgkmcnt(" #n ")" ::: "memory")
#define PG8_BAR __builtin_amdgcn_s_barrier()
#define PG8_SCHED __builtin_amdgcn_sched_barrier(0)
    Unit cur, nxt; int ui = 0;
    if (!S.next(0, cur)) return;
    f32x4 acc[2][2][4][2];
#pragma unroll
    for (int a = 0; a < 2; ++a)
#pragma unroll
        for (int b = 0; b < 2; ++b)
#pragma unroll
            for (int m = 0; m < 4; ++m)
#pragma unroll
                for (int n = 0; n < 2; ++n) acc[a][b][m][n] = (f32x4){0.f, 0.f, 0.f, 0.f};
    bf16x8 At[4][2], B0[2][2], B1[2][2];
    const char* cA = (const char*)g.A + (size_t)cur.pm * tstep; const char* cB = (const char*)g.Bt + (size_t)cur.pn * tstep;
    S.a_ready(cur);
    if constexpr (SP2) {
        PG8_STAGE(PG8_SB(0, 0), cB, voffB); PG8_STAGE(PG8_SB(0, 1), cB + hstep, voffB); PG8_STAGE(PG8_SA(0, 0), cA, voffA); PG8_STAGE(PG8_SA(0, 1), cA + hstep, voffA);
        if (wr == 1) PG8_BAR;
        PG8_WAIT_V(2); PG8_BAR;
        PG8_STAGE(PG8_SB(1, 0), cB + kstep, voffB); PG8_STAGE(PG8_SA(1, 0), cA + kstep, voffA); PG8_STAGE(PG8_SB(1, 1), cB + hstep + kstep, voffB);
        PG8_WAIT_V(6); PG8_BAR;
    } else {
        PG8_STAGE(PG8_SB(0, 0), cB, voffB); PG8_STAGE(PG8_SA(0, 0), cA, voffA); PG8_STAGE(PG8_SB(0, 1), cB + hstep, voffB); PG8_STAGE(PG8_SA(0, 1), cA + hstep, voffA);
        if (wr == 1) PG8_BAR;
        PG8_WAIT_V(4); PG8_BAR;
        PG8_STAGE(PG8_SB(1, 0), cB + kstep, voffB); PG8_STAGE(PG8_SA(1, 0), cA + kstep, voffA); PG8_STAGE(PG8_SB(1, 1), cB + hstep + kstep, voffB);
        PG8_WAIT_V(6); PG8_BAR;
    }
    for (;;) {
        const bool has_next = S.next(ui + 1, nxt);
        const char* nA = has_next ? (const char*)g.A + (size_t)nxt.pm * tstep : cA; const char* nB = has_next ? (const char*)g.Bt + (size_t)nxt.pn * tstep : cB;
        for (int t = 0; t < nt; t += 2) {
            const bool last = (t == nt - 2);
            const char* a1 = cA + (size_t)(t + 1) * kstep;
            const char* a2 = last ? nA : cA + (size_t)(t + 2) * kstep; const char* b2 = last ? nB : cB + (size_t)(t + 2) * kstep;
            const char* a3 = a2 + kstep; const char* b3 = b2 + kstep;
            if (last && has_next) S.a_ready(nxt);
            if constexpr (SP2) {
            PG8_LDB(B0, 0, 0); PG8_LDB(B1, 0, 1); PG8_SCHED; PG8_LDA(At, 0, 0); PG8_STAGE(PG8_SA(1, 1), a1 + hstep, voffA);
            PG8_WAIT_V(8); PG8_WAIT_L(0); PG8_BAR; PG8_MMA(0, 0, At, B0); PG8_MMA(0, 1, At, B1); PG8_BAR; PG8_SCHED;
            PG8_LDA(At, 0, 1); PG8_STAGE(PG8_SB(0, 0), b2, voffB); PG8_STAGE(PG8_SB(0, 1), b2 + hstep, voffB); PG8_STAGE(PG8_SA(0, 0), a2, voffA);
            PG8_WAIT_V(8); PG8_WAIT_L(0); PG8_BAR; PG8_MMA(1, 0, At, B0); PG8_MMA(1, 1, At, B1); PG8_BAR; PG8_SCHED;
            PG8_LDB(B0, 1, 0); PG8_LDB(B1, 1, 1); PG8_SCHED; PG8_LDA(At, 1, 0); PG8_STAGE(PG8_SA(0, 1), a2 + hstep, voffA);
            PG8_WAIT_V(8); PG8_WAIT_L(0); PG8_BAR; PG8_MMA(0, 0, At, B0); PG8_MMA(0, 1, At, B1); PG8_BAR; PG8_SCHED;
            PG8_LDA(At, 1, 1); PG8_STAGE(PG8_SB(1, 0), b3, voffB); PG8_STAGE(PG8_SB(1, 1), b3 + hstep, voffB); PG8_STAGE(PG8_SA(1, 0), a3, voffA);
            PG8_WAIT_V(8); PG8_WAIT_L(0); PG8_BAR; PG8_MMA(1, 0, At, B0); PG8_MMA(1, 1, At, B1); PG8_BAR; PG8_SCHED;
            } else {
            PG8_LDB(B0, 0, 0); PG8_SCHED; PG8_LDA(At, 0, 0); PG8_STAGE(PG8_SA(1, 1), a1 + hstep, voffA);
            PG8_WAIT_L(8); PG8_BAR; PG8_WAIT_L(0); PG8_MMA(0, 0, At, B0); PG8_BAR; PG8_SCHED;
            PG8_LDB(B1, 0, 1); PG8_STAGE(PG8_SB(0, 0), b2, voffB);
            PG8_BAR; PG8_WAIT_L(0); PG8_MMA(0, 1, At, B1); PG8_BAR;
            PG8_LDA(At, 0, 1); PG8_STAGE(PG8_SA(0, 0), a2, voffA);
            PG8_BAR; PG8_WAIT_L(0); PG8_MMA(1, 0, At, B0); PG8_BAR; PG8_SCHED;
            PG8_STAGE(PG8_SB(0, 1), b2 + hstep, voffB);
            PG8_WAIT_V(6); PG8_BAR; PG8_MMA(1, 1, At, B1); PG8_BAR;
            PG8_LDB(B0, 1, 0); PG8_SCHED; PG8_LDA(At, 1, 0); PG8_STAGE(PG8_SA(0, 1), a2 + hstep, voffA);
            PG8_WAIT_L(8); PG8_BAR; PG8_WAIT_L(0); PG8_MMA(0, 0, At, B0); PG8_BAR; PG8_SCHED;
            PG8_LDB(B1, 1, 1); PG8_STAGE(PG8_SB(1, 0), b3, voffB);
            PG8_BAR; PG8_WAIT_L(0); PG8_MMA(0, 1, At, B1); PG8_BAR;
            PG8_LDA(At, 1, 1); PG8_STAGE(PG8_SA(1, 0), a3, voffA);
            PG8_BAR; PG8_WAIT_L(0); PG8_MMA(1, 0, At, B0); PG8_BAR; PG8_SCHED;
            PG8_STAGE(PG8_SB(1, 1), b3 + hstep, voffB);
            PG8_WAIT_V(6); PG8_BAR; PG8_MMA(1, 1, At, B1); PG8_BAR;
            }
        }
        if constexpr (ALIGN_EPI) { if (wr == 0) PG8_BAR; }
        if constexpr (!Epi::AFTER_DRAIN) { E(acc, cur, wr, wc, fr, fq); S.done(cur); }
        if (!has_next) break;
#pragma unroll
        for (int a = 0; a < 2; ++a)
#pragma unroll
            for (int b = 0; b < 2; ++b)
#pragma unroll
                for (int m = 0; m < 4; ++m)
#pragma unroll
                    for (int n = 0; n < 2; ++n) acc[a][b][m][n] = (f32x4){0.f, 0.f, 0.f, 0.f};
        cur = nxt; cA = nA; cB = nB; ++ui;
        if constexpr (ALIGN_EPI) { if (wr == 1) PG8_BAR; }
    }
    PG8_WAIT_V(0);
    if constexpr (!ALIGN_EPI) { if (wr == 0) PG8_BAR; }
    PG8_BAR;
    if constexpr (Epi::AFTER_DRAIN) { E.fused(acc, cur, wr, wc, fr, fq, lds, wid, lane); S.done(cur); }
#undef PG8_SA
#undef PG8_SB
#undef PG8_STAGE
#undef PG8_LDA
#undef PG8_LDB
#undef PG8_MMA
#undef PG8_WAIT_V
#undef PG8_WAIT_L
#undef PG8_BAR
#undef PG8_SCHED
}
}
#undef LAS
namespace att {
#define LAS __attribute__((address_space(3)))
typedef unsigned short bf16_t;
typedef short bf16x8 __attribute__((ext_vector_type(8)));
typedef float f32x16 __attribute__((ext_vector_type(16)));
typedef unsigned u32x4 __attribute__((ext_vector_type(4)));
typedef unsigned u32x2 __attribute__((ext_vector_type(2)));
typedef float f32x4 __attribute__((ext_vector_type(4)));
typedef float f32x4s __attribute__((ext_vector_type(4)));
constexpr int ROWB = 144, SLOT = 64 * ROWB;
constexpr int KOFF = 0, VOFF = 3 * SLOT;
constexpr int ATT_LDS = 5 * SLOT;
constexpr float THR = 8.f;
#ifndef PROBE_FORCE_REDO
#define PROBE_FORCE_REDO 0
#endif
#ifndef PROBE_NOMAX
#define PROBE_NOMAX 0
#endif
#define MFMA32(a, b, c) __builtin_amdgcn_mfma_f32_32x32x16_bf16((a), (b), (c), 0, 0, 0)
DI float hmax(float m) { auto rr = __builtin_amdgcn_permlane32_swap(__float_as_uint(m), __float_as_uint(m), false, false); return __builtin_fmaxf(__uint_as_float(rr[0]), __uint_as_float(rr[1])); }
DI float hsum(float m) { auto rr = __builtin_amdgcn_permlane32_swap(__float_as_uint(m), __float_as_uint(m), false, false); return __uint_as_float(rr[0]) + __uint_as_float(rr[1]); }
DI f32x16 splat16(float v) { return (f32x16){v, v, v, v, v, v, v, v, v, v, v, v, v, v, v, v}; }
DI float mx3(float a, float b, float c) { return __builtin_fmaxf(__builtin_fmaxf(a, b), c); }
DI float rowmax(const f32x16& p0, const f32x16& p1) {
    const float NEG = -3.0e38f;
    float a = mx3(NEG, p0[0], p0[1]), b = mx3(NEG, p1[0], p1[1]);
#pragma unroll
    for (int r = 2; r < 16; r += 2) { a = mx3(a, p0[r], p0[r + 1]); b = mx3(b, p1[r], p1[r + 1]); }
    a = __builtin_fmaxf(a, b);
    auto rr = __builtin_amdgcn_permlane32_swap(__float_as_uint(a), __float_as_uint(a), false, false);
    return mx3(NEG, __uint_as_float(rr[0]), __uint_as_float(rr[1]));
}
DI void reference(f32x16& p0, f32x16& p1, float& mref, float& l, f32x16& negm, f32x16& o0, f32x16& o1, bool first, f32x16* ls = nullptr, f32x4s* l4 = nullptr) {
#if PROBE_NOMAX
    if (!first) return;
#endif
    const float mx = rowmax(p0, p1);
    if (first) {
        mref = mx;
#pragma unroll
        for (int r = 0; r < 16; ++r) { p0[r] -= mx; p1[r] -= mx; }
        negm = splat16(-mx);
    } else if (__any(mx > THR)) {
        const float dl = __builtin_fmaxf(mx, 0.f);
        mref += dl;
        const float al = __builtin_amdgcn_exp2f(-dl);
        l *= al;
#pragma unroll
        for (int r = 0; r < 16; ++r) { p0[r] -= dl; p1[r] -= dl; o0[r] *= al; o1[r] *= al; }
        if (ls) { (*ls)[0] *= al; }
        if (l4) { (*l4)[0] *= al; }
        negm = splat16(-mref);
    }
}
template <int DS0, int NDS>
DI void qk_issue(f32x16& n0, f32x16& n1, const LAS unsigned char* kb, const bf16x8 (&qf)[4], const f32x16& c) {
#pragma unroll
    for (int ds = DS0; ds < DS0 + NDS; ++ds) {
        const bf16x8 a0 = *(const LAS bf16x8*)(kb + ds * 32), a1 = *(const LAS bf16x8*)(kb + 32 * ROWB + ds * 32);
        if (ds == DS0) { n0 = MFMA32(a0, qf[ds], c); n1 = MFMA32(a1, qf[ds], c); }
        else { n0 = MFMA32(a0, qf[ds], n0); n1 = MFMA32(a1, qf[ds], n1); } }
}
template <bool NOEXP = false, bool SUM = true>
DI void exp_pack(f32x16& p0, f32x16& p1, float& l, bf16x8 (&pb)[4]) {
#pragma unroll
    for (int r = 0; r < 16; ++r) { if (NOEXP) { p0[r] = p0[r] * 0.001f; p1[r] = p1[r] * 0.001f; } else { p0[r] = __builtin_amdgcn_exp2f(p0[r]); p1[r] = __builtin_amdgcn_exp2f(p1[r]); } }
    if (SUM) {
    float s0 = 0.f, s1 = 0.f;
#pragma unroll
    for (int r = 0; r < 16; r += 2) { s0 += p0[r] + p1[r]; s1 += p0[r + 1] + p1[r + 1]; }
    l += s0 + s1; }
    u32x4 w;
    w.x = cvtpk(p0[0], p0[1]); w.y = cvtpk(p0[2], p0[3]); w.z = cvtpk(p0[4], p0[5]); w.w = cvtpk(p0[6], p0[7]); pb[0] = __builtin_bit_cast(bf16x8, w);
    w.x = cvtpk(p0[8], p0[9]); w.y = cvtpk(p0[10], p0[11]); w.z = cvtpk(p0[12], p0[13]); w.w = cvtpk(p0[14], p0[15]); pb[1] = __builtin_bit_cast(bf16x8, w);
    w.x = cvtpk(p1[0], p1[1]); w.y = cvtpk(p1[2], p1[3]); w.z = cvtpk(p1[4], p1[5]); w.w = cvtpk(p1[6], p1[7]); pb[2] = __builtin_bit_cast(bf16x8, w);
    w.x = cvtpk(p1[8], p1[9]); w.y = cvtpk(p1[10], p1[11]); w.z = cvtpk(p1[12], p1[13]); w.w = cvtpk(p1[14], p1[15]); pb[3] = __builtin_bit_cast(bf16x8, w);
}
DI void pv_issue(f32x16& o0, f32x16& o1, const LAS unsigned char* vb, const bf16x8 (&pb)[4]) {
#pragma unroll
    for (int s = 0; s < 4; ++s) {
        const bf16x8 v0 = *(const LAS bf16x8*)(vb + s * 32), v1 = *(const LAS bf16x8*)(vb + 32 * ROWB + s * 32);
        o0 = MFMA32(v0, pb[s], o0); o1 = MFMA32(v1, pb[s], o1); }
}

template <int DS0, int NDS>
DI void kload(bf16x8 (&kf)[2 * NDS], const LAS unsigned char* kb) {
#pragma unroll
    for (int i = 0; i < NDS; ++i) { kf[2 * i] = *(const LAS bf16x8*)(kb + (DS0 + i) * 32); kf[2 * i + 1] = *(const LAS bf16x8*)(kb + 32 * ROWB + (DS0 + i) * 32); }
}
template <int DS0, int NDS>
DI void qk_mma(f32x16& n0, f32x16& n1, const bf16x8 (&kf)[2 * NDS], const bf16x8 (&qf)[4], const f32x16& c) {
#pragma unroll
    for (int i = 0; i < NDS; ++i) {
        if (i == 0) { n0 = MFMA32(kf[0], qf[DS0], c); n1 = MFMA32(kf[1], qf[DS0], c); }
        else { n0 = MFMA32(kf[2 * i], qf[DS0 + i], n0); n1 = MFMA32(kf[2 * i + 1], qf[DS0 + i], n1); } }
}
DI void vload(bf16x8 (&vf)[8], const LAS unsigned char* vb) {
#pragma unroll
    for (int s = 0; s < 4; ++s) { vf[2 * s] = *(const LAS bf16x8*)(vb + s * 32); vf[2 * s + 1] = *(const LAS bf16x8*)(vb + 32 * ROWB + s * 32); }
}
DI void pv_mma(f32x16& o0, f32x16& o1, const bf16x8 (&vf)[8], const bf16x8 (&pb)[4]) {
#pragma unroll
    for (int s = 0; s < 4; ++s) { o0 = MFMA32(vf[2 * s], pb[s], o0); o1 = MFMA32(vf[2 * s + 1], pb[s], o1); }
}
DI void pv_mma_sum(f32x16& o0, f32x16& o1, f32x16& ls, const bf16x8 (&vf)[8], const bf16x8 (&pb)[4]) {
    const bf16x8 ones = {0x3f80, 0x3f80, 0x3f80, 0x3f80, 0x3f80, 0x3f80, 0x3f80, 0x3f80};
#pragma unroll
    for (int s = 0; s < 4; ++s) { o0 = MFMA32(vf[2 * s], pb[s], o0); o1 = MFMA32(vf[2 * s + 1], pb[s], o1); ls = MFMA32(ones, pb[s], ls); }
}
#define SBAR() __builtin_amdgcn_sched_barrier(0)

DI void e8(f32x16& p, int base_is_8, bf16x8& pb) {
    u32x4 w;
    if (!base_is_8) { _Pragma("unroll") for (int r = 0; r < 8; ++r) p[r] = __builtin_amdgcn_exp2f(p[r]);
        w.x = cvtpk(p[0], p[1]); w.y = cvtpk(p[2], p[3]); w.z = cvtpk(p[4], p[5]); w.w = cvtpk(p[6], p[7]); }
    else { _Pragma("unroll") for (int r = 8; r < 16; ++r) p[r] = __builtin_amdgcn_exp2f(p[r]);
        w.x = cvtpk(p[8], p[9]); w.y = cvtpk(p[10], p[11]); w.z = cvtpk(p[12], p[13]); w.w = cvtpk(p[14], p[15]); }
    pb = __builtin_bit_cast(bf16x8, w);
}
DI void half_step_std(f32x16& c0, f32x16& c1, f32x16& n0, f32x16& n1, const bf16x8 (&kf)[8], const bf16x8 (&vf)[8], const bf16x8 (&qf)[4], const f32x16& ng,
                      f32x16& o0, f32x16& o1, f32x16& ls) {
    const bf16x8 ones = {0x3f80, 0x3f80, 0x3f80, 0x3f80, 0x3f80, 0x3f80, 0x3f80, 0x3f80};
    bf16x8 pb0, pb1, pb2, pb3;
    SBAR();
    e8(c0, 0, pb0);
    n0 = MFMA32(kf[0], qf[0], ng); n1 = MFMA32(kf[1], qf[0], ng);
    SBAR();
    e8(c0, 1, pb1);
    n0 = MFMA32(kf[2], qf[1], n0); n1 = MFMA32(kf[3], qf[1], n1);
    o0 = MFMA32(vf[0], pb0, o0); o1 = MFMA32(vf[1], pb0, o1); ls = MFMA32(ones, pb0, ls);
    SBAR();
    e8(c1, 0, pb2);
    n0 = MFMA32(kf[4], qf[2], n0); n1 = MFMA32(kf[5], qf[2], n1);
    o0 = MFMA32(vf[2], pb1, o0); o1 = MFMA32(vf[3], pb1, o1); ls = MFMA32(ones, pb1, ls);
    SBAR();
    e8(c1, 1, pb3);
    n0 = MFMA32(kf[6], qf[3], n0); n1 = MFMA32(kf[7], qf[3], n1);
    o0 = MFMA32(vf[4], pb2, o0); o1 = MFMA32(vf[5], pb2, o1); ls = MFMA32(ones, pb2, ls);
    SBAR();
    o0 = MFMA32(vf[6], pb3, o0); o1 = MFMA32(vf[7], pb3, o1); ls = MFMA32(ones, pb3, ls);
}

DI bf16x8 sum_selector(int lane) {
    const int row = lane & 15, g = lane >> 4;
    const bool on = ((row == 0 || row == 8) && (g == 0 || g == 2)) || ((row == 4 || row == 12) && (g == 1 || g == 3));
    const short v = on ? (short)0x3f80 : (short)0;
    return (bf16x8){v, v, v, v, v, v, v, v};
}
#define MFMA16(a, b, c) __builtin_amdgcn_mfma_f32_16x16x32_bf16((a), (b), (c), 0, 0, 0)

DI void pv_mma_sel(f32x16& o0, f32x16& o1, f32x4s& l4, const bf16x8& asel, const bf16x8 (&vf)[8], const bf16x8 (&pb)[4]) {
#pragma unroll
    for (int s = 0; s < 4; ++s) { o0 = MFMA32(vf[2 * s], pb[s], o0); o1 = MFMA32(vf[2 * s + 1], pb[s], o1); l4 = MFMA16(asel, pb[s], l4); }
}

DI void e8s(f32x16& p, int hi8, bf16x8& pb, float& l) {
    u32x4 w; float s;
    if (!hi8) { _Pragma("unroll") for (int r = 0; r < 8; ++r) p[r] = __builtin_amdgcn_exp2f(p[r]);
        s = ((p[0] + p[1]) + (p[2] + p[3])) + ((p[4] + p[5]) + (p[6] + p[7]));
        w.x = cvtpk(p[0], p[1]); w.y = cvtpk(p[2], p[3]); w.z = cvtpk(p[4], p[5]); w.w = cvtpk(p[6], p[7]); }
    else { _Pragma("unroll") for (int r = 8; r < 16; ++r) p[r] = __builtin_amdgcn_exp2f(p[r]);
        s = ((p[8] + p[9]) + (p[10] + p[11])) + ((p[12] + p[13]) + (p[14] + p[15]));
        w.x = cvtpk(p[8], p[9]); w.y = cvtpk(p[10], p[11]); w.z = cvtpk(p[12], p[13]); w.w = cvtpk(p[14], p[15]); }
    l += s; pb = __builtin_bit_cast(bf16x8, w);
}
template <int DS0>
DI void half_step_diff(f32x16& c0, f32x16& c1, f32x16& n0, f32x16& n1, const bf16x8 (&kf)[4], const bf16x8 (&vf)[8], const bf16x8 (&qf)[4], const f32x16& ng,
                       f32x16& o0, f32x16& o1, f32x4s& l4, const bf16x8& asel) {
    bf16x8 pb0, pb1, pb2, pb3;
    SBAR();
    e8(c0, 0, pb0);
    n0 = MFMA32(kf[0], qf[DS0], ng); n1 = MFMA32(kf[1], qf[DS0], ng);
    SBAR();
    e8(c0, 1, pb1);
    n0 = MFMA32(kf[2], qf[DS0 + 1], n0); n1 = MFMA32(kf[3], qf[DS0 + 1], n1);
    o0 = MFMA32(vf[0], pb0, o0); o1 = MFMA32(vf[1], pb0, o1); l4 = MFMA16(asel, pb0, l4);
    SBAR();
    e8(c1, 0, pb2);
    o0 = MFMA32(vf[2], pb1, o0); o1 = MFMA32(vf[3], pb1, o1); l4 = MFMA16(asel, pb1, l4);
    SBAR();
    e8(c1, 1, pb3);
    o0 = MFMA32(vf[4], pb2, o0); o1 = MFMA32(vf[5], pb2, o1); l4 = MFMA16(asel, pb2, l4);
    SBAR();
    o0 = MFMA32(vf[6], pb3, o0); o1 = MFMA32(vf[7], pb3, o1); l4 = MFMA16(asel, pb3, l4);
}

template <bool DIFF, bool NOEXP = false, bool FAST = false>
DI bool attn_unit(LAS unsigned char* lds, const bf16_t* __restrict__ Qp, const bf16_t* __restrict__ Kp, const bf16_t* __restrict__ Vtp, int nk, bf16_t* Gp,
                  const float* lamp, const float* subln, int layer, bool dry, int wave_s) {
    const int tid_ = (wave_s << 6) | lane_now();
    const int tid = tid_, lane = tid & 63, r32 = lane & 31, hi = lane >> 5; const int wid = __builtin_amdgcn_readfirstlane(tid >> 6);
    bf16x8 qf[4];
    { const bf16_t* qrow = Qp + (size_t)(wid * 32 + r32) * 64 + hi * 8;
#pragma unroll
      for (int ds = 0; ds < 4; ++ds) qf[ds] = *(const bf16x8*)(qrow + ds * 16); }
    const int lrow = tid >> 3, lch = tid & 7;
    const bf16_t* kg = Kp + (size_t)lrow * 64 + lch * 8;
    const bf16_t* vg = Vtp + (size_t)lrow * nk + lch * 8;
    const unsigned lw = lrow * ROWB + lch * 16;
    const int NT = nk >> 6;
    u32x4 kreg, vreg;
    { const u32x4 k0 = *(const u32x4*)kg, v0 = *(const u32x4*)vg, k1 = *(const u32x4*)(kg + 4096);
      *(LAS u32x4*)(lds + KOFF + lw) = k0; *(LAS u32x4*)(lds + VOFF + lw) = v0; *(LAS u32x4*)(lds + KOFF + SLOT + lw) = k1; }
    kreg = *(const u32x4*)(kg + (size_t)2 * 4096); vreg = *(const u32x4*)(vg + 64);
    __syncthreads();
    float m1 = 0.f, l1 = 0.f, m2 = 0.f, l2 = 0.f;
    f32x16 oa0, oa1, ob0, ob1, ng1, ng2;
#pragma unroll
    for (int r = 0; r < 16; ++r) { oa0[r] = 0.f; oa1[r] = 0.f; ob0[r] = 0.f; ob1[r] = 0.f; }
    ng1 = splat16(0.f); ng2 = splat16(0.f);
    const unsigned fro = r32 * ROWB + hi * 16;
    f32x16 pa0, pa1, pc0, pc1;
    qk_issue<0, DIFF ? 2 : 4>(pa0, pa1, lds + KOFF + fro, qf, ng1);
    int kc = 0, kn = SLOT, kw = 2 * SLOT;
#ifndef PROBE_VAR
#define PROBE_VAR 0
#endif
#define STAGE(t) do { if (PROBE_VAR == 1 && dry) { const int o_ = kc; kc = kn; kn = kw; kw = o_; break; } *(LAS u32x4*)(lds + KOFF + kw + lw) = kreg; *(LAS u32x4*)(lds + VOFF + (((t) + 1) & 1) * SLOT + lw) = vreg; \
        { const int tk = (t) + 3 < NT ? (t) + 3 : NT - 1, tv = (t) + 2 < NT ? (t) + 2 : NT - 1; \
          kreg = *(const u32x4*)(kg + (size_t)tk * 4096); vreg = *(const u32x4*)(vg + (size_t)tv * 64); } \
        { const int o_ = kc; kc = kn; kn = kw; kw = o_; } \
        __syncthreads(); } while (0)
    if (DIFF) {
        f32x4s l4a = {0.f, 0.f, 0.f, 0.f}, l4b = {0.f, 0.f, 0.f, 0.f};
        const bf16x8 asel = sum_selector(lane);
        for (int t = 0; t < NT; ++t) {
            bf16x8 pb[4], kf[4], vf[8];
            kload<2, 2>(kf, lds + KOFF + kc + fro);
            if (!FAST) reference(pa0, pa1, m1, l1, ng1, oa0, oa1, t == 0, nullptr, &l4a);
            vload(vf, lds + VOFF + (t & 1) * SLOT + fro);
            { const f32x16 c = splat16(FAST ? 0.f : -m2);
              half_step_diff<2>(pa0, pa1, pc0, pc1, kf, vf, qf, c, oa0, oa1, l4a, asel); }
            SBAR();
            kload<0, 2>(kf, lds + KOFF + kn + fro);
            if (!FAST) reference(pc0, pc1, m2, l2, ng2, ob0, ob1, t == 0, nullptr, &l4b);

            { const f32x16 c = splat16(FAST ? 0.f : -m1);
              half_step_diff<0>(pc0, pc1, pa0, pa1, kf, vf, qf, c, ob0, ob1, l4b, asel); }
            STAGE(t);
        }
        l1 = 0.5f * l4a[0]; l2 = 0.5f * l4b[0];
    } else {
        f32x4s l4s = {0.f, 0.f, 0.f, 0.f};
        const bf16x8 asel = sum_selector(lane);
#define HALF_STD(CUR0, CUR1, NXT0, NXT1, t) do { bf16x8 pb[4], kf[8], vf[8]; \
            kload<0, 4>(kf, lds + KOFF + kn + fro); vload(vf, lds + VOFF + ((t) & 1) * SLOT + fro); \
            if (!FAST) reference(CUR0, CUR1, m1, l1, ng1, oa0, oa1, (t) == 0, nullptr, &l4s); \
            qk_mma<0, 4>(NXT0, NXT1, kf, qf, ng1); \
            exp_pack<NOEXP, false>(CUR0, CUR1, l1, pb); \
            pv_mma_sel(oa0, oa1, l4s, asel, vf, pb); \
            STAGE(t); } while (0)
        for (int t = 0; t < NT; t += 2) {
            HALF_STD(pa0, pa1, pc0, pc1, t);
            HALF_STD(pc0, pc1, pa0, pa1, t + 1);
        }
#undef HALF_STD
        l1 = 0.5f * l4s[0];
    }
#undef STAGE
    if (FAST) {
        bool bad = !(l1 < 1.0e30f && l1 > 1.0e-30f);
        if (DIFF) bad = bad || !(l2 < 1.0e30f && l2 > 1.0e-30f);
#if PROBE_FORCE_REDO
        bad = bad || ((wid & 1) == 0 && r32 == 3);
#endif
        LAS unsigned* fl = (LAS unsigned*)(lds + ATT_LDS);
        if (lane == 0) fl[wid] = 0u;
        if (__any(bad) && lane == 0) fl[wid] = 1u;
        __syncthreads();
        unsigned anyb = 0u;
#pragma unroll
        for (int w = 0; w < 8; ++w) anyb |= fl[w];
        if (anyb) return true;
    }
    const float inv1 = 1.f / hsum(l1);
    f32x16 oA[2] = {oa0, oa1};
    LAS unsigned char* stg = lds + 49152 + wid * 8704;
    if (DIFF) {
        const float lam = *lamp, out_scale = 1.f - (0.8f - 0.6f * __expf(-0.3f * (float)layer));
        const float inv2 = lam / hsum(l2);
        float ss = 0.f;
#pragma unroll
        for (int dh = 0; dh < 2; ++dh)
#pragma unroll
            for (int r = 0; r < 16; ++r) { const float x = oA[dh][r] * inv1 - (dh == 0 ? ob0[r] : ob1[r]) * inv2; oA[dh][r] = x; ss += x * x; }
        ss = hsum(ss);
        const float rn = rsqrtf(ss * (1.f / 64.f) + NORM_EPS) * out_scale;
#pragma unroll
        for (int dh = 0; dh < 2; ++dh)
#pragma unroll
            for (int g = 0; g < 4; ++g) {
                const int d0 = 32 * dh + 8 * g + 4 * hi;
                const f32x4 sw = *(const f32x4*)(subln + d0);
                *(LAS f32x4*)(stg + r32 * 272 + d0 * 4) = (f32x4){oA[dh][4 * g] * rn * sw[0], oA[dh][4 * g + 1] * rn * sw[1], oA[dh][4 * g + 2] * rn * sw[2], oA[dh][4 * g + 3] * rn * sw[3]}; }
    } else {
#pragma unroll
        for (int dh = 0; dh < 2; ++dh)
#pragma unroll
            for (int g = 0; g < 4; ++g)
                *(LAS f32x4*)(stg + r32 * 272 + (32 * dh + 8 * g + 4 * hi) * 4) = (f32x4){oA[dh][4 * g] * inv1, oA[dh][4 * g + 1] * inv1, oA[dh][4 * g + 2] * inv1, oA[dh][4 * g + 3] * inv1};
    }
    { bf16_t* gbase = Gp + (size_t)(wid * 32) * 1024;
      u32x4 gg[4];
#pragma unroll
      for (int k = 0; k < 4; ++k) { const int j = lane + 64 * k; gg[k] = *(const u32x4*)(gbase + (size_t)(j >> 3) * 1024 + (j & 7) * 8); }
#pragma unroll
      for (int k = 0; k < 4; ++k) { const int j = lane + 64 * k, row = j >> 3, c8 = j & 7;
          const f32x4 a = *(const LAS f32x4*)(stg + row * 272 + c8 * 32), b = *(const LAS f32x4*)(stg + row * 272 + c8 * 32 + 16);
          u32x4 w; w.x = cvtpk(a[0] * bf_lo(gg[k].x), a[1] * bf_hi(gg[k].x)); w.y = cvtpk(a[2] * bf_lo(gg[k].y), a[3] * bf_hi(gg[k].y));
          w.z = cvtpk(b[0] * bf_lo(gg[k].z), b[1] * bf_hi(gg[k].z)); w.w = cvtpk(b[2] * bf_lo(gg[k].w), b[3] * bf_hi(gg[k].w));
          if (!dry) *(u32x4*)(gbase + (size_t)row * 1024 + c8 * 8) = w; } }
    return false;
}

DI void attn_unit_split(LAS unsigned char* lds, const bf16_t* __restrict__ Qp, const bf16_t* __restrict__ Kp, const bf16_t* __restrict__ Vtp, int nk, bf16_t* Gp, bool dry, int wave_s) {
    const int tid_ = (wave_s << 6) | lane_now();
    const int tid = tid_, lane = tid & 63, r32 = lane & 31, hi = lane >> 5; const int wid = __builtin_amdgcn_readfirstlane(tid >> 6);
    const int grp = wid >> 2, wq = wid & 3;
    bf16x8 qf[4];
    { const bf16_t* qrow = Qp + (size_t)(wq * 32 + r32) * 64 + hi * 8;
#pragma unroll
      for (int ds = 0; ds < 4; ++ds) qf[ds] = *(const bf16x8*)(qrow + ds * 16); }
    const int NT = nk >> 7;
    const int gt = tid & 255, lrow = gt >> 3, lch = gt & 7;
    const bf16_t* kg = Kp + ((size_t)grp * NT * 64 + lrow) * 64 + lch * 8;
    const bf16_t* vg = Vtp + (size_t)lrow * nk + grp * NT * 64 + lch * 8;
    LAS unsigned char* ring = lds + grp * ATT_LDS;
    const unsigned lw = lrow * ROWB + lch * 16;
    u32x4 kreg0, kreg1, vreg0, vreg1;
    { const u32x4 k0 = *(const u32x4*)kg, k0b = *(const u32x4*)(kg + 32 * 64), v0 = *(const u32x4*)vg, v0b = *(const u32x4*)(vg + (size_t)32 * nk);
      const u32x4 k1 = *(const u32x4*)(kg + 4096), k1b = *(const u32x4*)(kg + 4096 + 32 * 64);
      *(LAS u32x4*)(ring + KOFF + lw) = k0; *(LAS u32x4*)(ring + KOFF + 32 * ROWB + lw) = k0b; *(LAS u32x4*)(ring + VOFF + lw) = v0; *(LAS u32x4*)(ring + VOFF + 32 * ROWB + lw) = v0b;
      *(LAS u32x4*)(ring + KOFF + SLOT + lw) = k1; *(LAS u32x4*)(ring + KOFF + SLOT + 32 * ROWB + lw) = k1b; }
    kreg0 = *(const u32x4*)(kg + (size_t)2 * 4096); kreg1 = *(const u32x4*)(kg + (size_t)2 * 4096 + 32 * 64);
    vreg0 = *(const u32x4*)(vg + 64); vreg1 = *(const u32x4*)(vg + (size_t)32 * nk + 64);
    __syncthreads();
    float m1 = 0.f, l1 = 0.f;
    f32x16 oa0, oa1, ng1 = splat16(0.f), ls = splat16(0.f);
#pragma unroll
    for (int r = 0; r < 16; ++r) { oa0[r] = 0.f; oa1[r] = 0.f; }
    const unsigned fro = r32 * ROWB + hi * 16;
    f32x16 pa0, pa1, pc0, pc1;
    { bf16x8 kf[8]; kload<0, 4>(kf, ring + KOFF + fro); qk_mma<0, 4>(pa0, pa1, kf, qf, ng1); }
    int kc = 0, kn = SLOT, kw = 2 * SLOT;
#define STAGE2(t) do { *(LAS u32x4*)(ring + KOFF + kw + lw) = kreg0; *(LAS u32x4*)(ring + KOFF + kw + 32 * ROWB + lw) = kreg1; \
        *(LAS u32x4*)(ring + VOFF + (((t) + 1) & 1) * SLOT + lw) = vreg0; *(LAS u32x4*)(ring + VOFF + (((t) + 1) & 1) * SLOT + 32 * ROWB + lw) = vreg1; \
        { const int tk = (t) + 3 < NT ? (t) + 3 : NT - 1, tv = (t) + 2 < NT ? (t) + 2 : NT - 1; \
          kreg0 = *(const u32x4*)(kg + (size_t)tk * 4096); kreg1 = *(const u32x4*)(kg + (size_t)tk * 4096 + 32 * 64); \
          vreg0 = *(const u32x4*)(vg + (size_t)tv * 64); vreg1 = *(const u32x4*)(vg + (size_t)32 * nk + (size_t)tv * 64); } \
        { const int o_ = kc; kc = kn; kn = kw; kw = o_; } \
        __syncthreads(); } while (0)
#define HALF_SPL(CUR0, CUR1, NXT0, NXT1, t) do { bf16x8 pb[4], kf[8], vf[8]; \
        kload<0, 4>(kf, ring + KOFF + kn + fro); vload(vf, ring + VOFF + ((t) & 1) * SLOT + fro); \
        reference(CUR0, CUR1, m1, l1, ng1, oa0, oa1, (t) == 0, &ls); \
        qk_mma<0, 4>(NXT0, NXT1, kf, qf, ng1); \
        exp_pack<false, false>(CUR0, CUR1, l1, pb); \
        pv_mma_sum(oa0, oa1, ls, vf, pb); \
        STAGE2(t); } while (0)
    for (int t = 0; t < NT; t += 2) {
        HALF_SPL(pa0, pa1, pc0, pc1, t);
        HALF_SPL(pc0, pc1, pa0, pa1, t + 1);
    }
#undef HALF_SPL
#undef STAGE2
    LAS float* mb = (LAS float*)lds + (wq * 64 + lane) * 35;
    if (grp == 1) {
        mb[0] = m1; mb[1] = ls[0];
#pragma unroll
        for (int r = 0; r < 16; ++r) { mb[2 + r] = oa0[r]; mb[18 + r] = oa1[r]; }
    }
    __syncthreads();
    if (grp == 0) {
        const float mB = mb[0], lB = mb[1];
        const float mm = __builtin_fmaxf(m1, mB), fa = __builtin_amdgcn_exp2f(m1 - mm), fb = __builtin_amdgcn_exp2f(mB - mm);
        const float inv = 1.f / (ls[0] * fa + lB * fb);
        const float ia = fa * inv, ib = fb * inv;
#pragma unroll
        for (int r = 0; r < 16; ++r) { oa0[r] = oa0[r] * ia + mb[2 + r] * ib; oa1[r] = oa1[r] * ia + mb[18 + r] * ib; }
        f32x16 oA[2] = {oa0, oa1};
        bf16_t* grow = Gp + (size_t)(wq * 32 + r32) * 1024 + 4 * hi;
#pragma unroll
        for (int dh = 0; dh < 2; ++dh)
#pragma unroll
            for (int g = 0; g < 4; ++g) {
                const u32x2 gg = *(const u32x2*)(grow + 32 * dh + 8 * g);
                const float a = oA[dh][4 * g] * bf_lo(gg.x), b = oA[dh][4 * g + 1] * bf_hi(gg.x);
                const float c = oA[dh][4 * g + 2] * bf_lo(gg.y), d = oA[dh][4 * g + 3] * bf_hi(gg.y);
                u32x2 w; w.x = cvtpk(a, b); w.y = cvtpk(c, d); if (!dry) *(u32x2*)(grow + 32 * dh + 8 * g) = w; }
    }
    __syncthreads();
}
}
#undef LAS
#define LAS __attribute__((address_space(3)))
typedef unsigned short bf16_t;
typedef float f32x4 __attribute__((ext_vector_type(4)));
typedef unsigned u32x4 __attribute__((ext_vector_type(4)));
typedef unsigned u32x2 __attribute__((ext_vector_type(2)));
constexpr int NB = 4, SEQ = 4096, DM = 1024, DEPTH = 4, DIN = 3072, NMEM = 256, MROWS = NB * SEQ;
constexpr int LDS_BYTES = 147456;
constexpr size_t MiB = 1u << 20;
constexpr size_t WS_WIN = 0;
constexpr size_t WS_WOUT = 24 * MiB;
constexpr size_t WS_WMEM = 32 * MiB;
constexpr size_t WS_XB = 36 * MiB;
constexpr size_t WS_MEMB = 68 * MiB;
constexpr size_t WS_QK = 70 * MiB;
constexpr size_t WS_VT = 118 * MiB;
constexpr size_t WS_KM = 134 * MiB;
constexpr size_t WS_VM = 136 * MiB;
constexpr size_t WS_G = 138 * MiB;
constexpr size_t WS_Y = 170 * MiB;
constexpr size_t WS_SSQ = 202 * MiB;
constexpr size_t WS_ROPE = 203 * MiB;
constexpr size_t WS_RSX = 204 * MiB;
constexpr size_t WS_RSM = 204 * MiB + 65536;
constexpr size_t WS_LAM = 204 * MiB + 131072;
constexpr size_t WS_BAR = 204 * MiB + 524288;
constexpr size_t WS_END = 205 * MiB;

DI float wave_sum(float v) {
#pragma unroll
    for (int o = 1; o < 64; o <<= 1) v += __shfl_xor(v, o);
    return v;
}
DI void transpose_item(const float* __restrict__ W, int K, int N, const float* __restrict__ gk, bf16_t* __restrict__ WT, bool headperm, LAS float* scr, int item, int lane) {
    const int nblk = N / 32, kb = item / nblk, nb = item % nblk, k0 = 64 * kb, n0 = 32 * nb;
    float wv[32];
#pragma unroll
    for (int i = 0; i < 32; ++i) wv[i] = W[(size_t)(k0 + 2 * i + (lane >> 5)) * N + n0 + (lane & 31)];
#pragma unroll
    for (int i = 0; i < 32; ++i) { const int kk = 2 * i + (lane >> 5); float w = wv[i]; if (gk) w *= gk[k0 + kk]; scr[kk * 33 + (lane & 31)] = w; }
    asm volatile("s_waitcnt lgkmcnt(0)" ::: "memory");
    int drow0 = n0; if (headperm) { const int w = n0 & 255; drow0 = (n0 & ~255) + 128 * ((w & 63) >> 5) + 32 * (w >> 6); }
    const int c = lane & 7;
#pragma unroll
    for (int j = 0; j < 4; ++j) { const int n = (lane >> 3) + 8 * j; const LAS float* s = scr + (8 * c) * 33 + n;
        u32x4 o; o.x = cvtpk(s[0 * 33], s[1 * 33]); o.y = cvtpk(s[2 * 33], s[3 * 33]); o.z = cvtpk(s[4 * 33], s[5 * 33]); o.w = cvtpk(s[6 * 33], s[7 * 33]);
        *(u32x4*)(WT + (size_t)(drow0 + n) * K + k0 + 8 * c) = o; }
    asm volatile("s_waitcnt lgkmcnt(0)" ::: "memory");
}
DI void row_update(const float* __restrict__ xin, const bf16_t* __restrict__ y, const float* __restrict__ ssq, const float* __restrict__ gpost, float* xout, bf16_t* xb, float* rs_out, int lane) {
    f32x4 v[4];
    if (xin) {
#pragma unroll
        for (int j = 0; j < 4; ++j) v[j] = *(const f32x4*)(xin + 4 * lane + 256 * j);
    } else {
#pragma unroll
        for (int j = 0; j < 4; ++j) { const u32x2 xx = *(const u32x2*)(xb + 4 * lane + 256 * j); v[j][0] = bf_lo(xx.x); v[j][1] = bf_hi(xx.x); v[j][2] = bf_lo(xx.y); v[j][3] = bf_hi(xx.y); }
    }
    if (y) {
        float sy = 0.f;
#pragma unroll
        for (int i = 0; i < 4; ++i) { const f32x4 q = *(const f32x4*)(ssq + 4 * i); sy += (q[0] + q[1]) + (q[2] + q[3]); }
        const float ry = rsqrtf(sy * (1.f / 1024.f) + NORM_EPS);
#pragma unroll
        for (int j = 0; j < 4; ++j) { const u32x2 yy = *(const u32x2*)(y + 4 * lane + 256 * j); const f32x4 g = *(const f32x4*)(gpost + 4 * lane + 256 * j);
            v[j][0] += bf_lo(yy.x) * ry * g[0]; v[j][1] += bf_hi(yy.x) * ry * g[1]; v[j][2] += bf_lo(yy.y) * ry * g[2]; v[j][3] += bf_hi(yy.y) * ry * g[3]; }
    }
    float s = 0.f;
#pragma unroll
    for (int j = 0; j < 4; ++j) s += (v[j][0] * v[j][0] + v[j][1] * v[j][1]) + (v[j][2] * v[j][2] + v[j][3] * v[j][3]);
    s = wave_sum(s);
    if (xout) {
#pragma unroll
        for (int j = 0; j < 4; ++j) *(f32x4*)(xout + 4 * lane + 256 * j) = v[j];
    } else {
#pragma unroll
        for (int j = 0; j < 4; ++j) { u32x2 w; w.x = cvtpk(v[j][0], v[j][1]); w.y = cvtpk(v[j][2], v[j][3]); *(u32x2*)(xb + 4 * lane + 256 * j) = w; }
        if (lane == 0) *rs_out = rsqrtf(s * (1.f / 1024.f) + NORM_EPS);
    }
}
template <int R>
DI void rows_update(const float* __restrict__ xin, const bf16_t* __restrict__ y, const float* __restrict__ ssq, const float* __restrict__ gpost, float* xout, bf16_t* xb, float* rs_out, int m0, int mstep, int lane) {
    f32x4 v[R][4]; u32x2 yy[R][4]; f32x4 q[R][4];
#pragma unroll
    for (int r = 0; r < R; ++r) { const size_t m = m0 + r * mstep;
        if (xin) {
#pragma unroll
            for (int j = 0; j < 4; ++j) v[r][j] = *(const f32x4*)(xin + m * DM + 4 * lane + 256 * j);
        } else {
#pragma unroll
            for (int j = 0; j < 4; ++j) { const u32x2 xx = *(const u32x2*)(xb + m * DM + 4 * lane + 256 * j); v[r][j][0] = bf_lo(xx.x); v[r][j][1] = bf_hi(xx.x); v[r][j][2] = bf_lo(xx.y); v[r][j][3] = bf_hi(xx.y); }
        }
        if (y) {
#pragma unroll
            for (int j = 0; j < 4; ++j) { yy[r][j] = *(const u32x2*)(y + m * DM + 4 * lane + 256 * j); q[r][j] = *(const f32x4*)(ssq + m * 16 + 4 * j); }
        }
    }
    if (y) {
#pragma unroll
        for (int r = 0; r < R; ++r) {
            float sy = 0.f;
#pragma unroll
            for (int i = 0; i < 4; ++i) sy += (q[r][i][0] + q[r][i][1]) + (q[r][i][2] + q[r][i][3]);
            const float ry = rsqrtf(sy * (1.f / 1024.f) + NORM_EPS);
#pragma unroll
            for (int j = 0; j < 4; ++j) { const f32x4 g = *(const f32x4*)(gpost + 4 * lane + 256 * j);
                v[r][j][0] += bf_lo(yy[r][j].x) * ry * g[0]; v[r][j][1] += bf_hi(yy[r][j].x) * ry * g[1]; v[r][j][2] += bf_lo(yy[r][j].y) * ry * g[2]; v[r][j][3] += bf_hi(yy[r][j].y) * ry * g[3]; }
        }
    }
#pragma unroll
    for (int r = 0; r < R; ++r) { const size_t m = m0 + r * mstep;
        float s = 0.f;
#pragma unroll
        for (int j = 0; j < 4; ++j) s += (v[r][j][0] * v[r][j][0] + v[r][j][1] * v[r][j][1]) + (v[r][j][2] * v[r][j][2] + v[r][j][3] * v[r][j][3]);
        s = wave_sum(s);
        if (xout) {
#pragma unroll
            for (int j = 0; j < 4; ++j) *(f32x4*)(xout + m * DM + 4 * lane + 256 * j) = v[r][j];
        } else {
#pragma unroll
            for (int j = 0; j < 4; ++j) { u32x2 w; w.x = cvtpk(v[r][j][0], v[r][j][1]); w.y = cvtpk(v[r][j][2], v[r][j][3]); *(u32x2*)(xb + m * DM + 4 * lane + 256 * j) = w; }
            if (lane == 0) rs_out[m] = rsqrtf(s * (1.f / 1024.f) + NORM_EPS);
        }
    }
}
DI void rope_entry(int idx, float2* out) {
    const int pos = idx >> 4, j = idx & 15;
    const int jl = j & 3, jh = j >> 2;
    const double ml = jl == 0 ? 1.0 : (jl == 1 ? 0.5623413251903491 : (jl == 2 ? 0.31622776601683794 : 0.1778279410038923));
    const double mh = jh == 0 ? 1.0 : (jh == 1 ? 0.1 : (jh == 2 ? 0.01 : 0.001));
    const float inv = (float)(ml * mh);
    const float angf = (float)pos * inv;
    const double a = (double)angf;
    const double kq = __builtin_rint(a * 0.63661977236758134308);
    double r = __builtin_fma(-kq, 1.57079632679489655800e+00, a); r = __builtin_fma(-kq, 6.12323399573676603587e-17, r);
    const int q = ((int)kq) & 3;
    const double r2 = r * r;
    const double sn = r * (1.0 + r2 * (-1.0 / 6 + r2 * (1.0 / 120 + r2 * (-1.0 / 5040 + r2 * (1.0 / 362880 + r2 * (-1.0 / 39916800 + r2 * (1.0 / 6227020800.0)))))));
    const double cs = 1.0 + r2 * (-0.5 + r2 * (1.0 / 24 + r2 * (-1.0 / 720 + r2 * (1.0 / 40320 + r2 * (-1.0 / 3628800 + r2 * (1.0 / 479001600.0 + r2 * (-1.0 / 87178291200.0)))))));
    const double c = q == 0 ? cs : (q == 1 ? -sn : (q == 2 ? -cs : sn));
    const double s = q == 0 ? sn : (q == 1 ? cs : (q == 2 ? -sn : -cs));
    *out = make_float2((float)c, (float)s);
}

#ifndef PROBE_REP
#define PROBE_REP 0
#endif
#ifndef PROBE_VAR
#define PROBE_VAR 0
#endif
#ifndef GQA_SPLIT
#define GQA_SPLIT 0
#endif
#ifndef SCHED_XCDHALF
#define SCHED_XCDHALF 1
#endif
#if PROBE_VAR == 2
#define ATT_CALL(D, ...) do { if (rep == 0) att::attn_unit<D, true>(__VA_ARGS__); else att::attn_unit<D, false>(__VA_ARGS__); } while (0)
#else
#define ATT_CALL(D, ...) do { if (!safe_pass) { if (att::attn_unit<D, false, true>(__VA_ARGS__)) redo |= 1u << unit_no; } else if ((redo >> unit_no) & 1u) att::attn_unit<D, false, false>(__VA_ARGS__); ++unit_no; } while (0)
#endif
#define XB_TMO      128
#define XB_XCNT(j)  (256  + 64 * (j))
#define XB_XSUB(j)  (1280 + 64 * (j))
#define XB_XGEN(j)  (2304 + 64 * (j))
#define XB_TOP      3328
#define XB_TOPGEN   3392
#define XCD_BAR_WORDS 3456
#define XB_SPIN_CAP (1u << 18)

__device__ __forceinline__ unsigned xb_ld(unsigned* p)              { return __hip_atomic_load(p, __ATOMIC_RELAXED, __HIP_MEMORY_SCOPE_AGENT); }
__device__ __forceinline__ unsigned xb_add(unsigned* p, unsigned v) { return __hip_atomic_fetch_add(p, v, __ATOMIC_RELAXED, __HIP_MEMORY_SCOPE_AGENT); }
__device__ __forceinline__ unsigned xb_xcc_id() { return (unsigned)__builtin_amdgcn_s_getreg((3 << 11) | 20) & 0xFu; }
#define XB_SPIN(cond, bar) do { unsigned _sp = 0; while (cond) { __builtin_amdgcn_s_sleep(1); \
    if ((++_sp & 255u) == 0u) { if (xb_ld(&(bar)[XB_TMO])) break; if (_sp > XB_SPIN_CAP) { atomicAdd(&(bar)[XB_TMO], 1u); break; } } } } while (0)

struct XcdBarrier {
    unsigned* bar; unsigned x;
    volatile LAS unsigned* st;
};

__device__ __forceinline__ XcdBarrier xcd_barrier_post(unsigned* bar, volatile LAS unsigned* st) {
    XcdBarrier b; b.bar = bar; b.x = xb_xcc_id(); b.st = st;
    if (threadIdx.x == 0) (void)xb_add(&bar[XB_XCNT(b.x)], 1u);
    return b;
}
__device__ __forceinline__ void xcd_barrier_complete(unsigned* bar, unsigned x, unsigned& nloc, unsigned& nx) {
    const unsigned G = gridDim.x * gridDim.y * gridDim.z;
    unsigned sum, cnt, mine, sp = 0u;
    for (;;) {
        sum = 0u; cnt = 0u; mine = 0u;
#pragma unroll
        for (unsigned j = 0; j < 16; ++j) { const unsigned c = xb_ld(&bar[XB_XCNT(j)]); sum += c; cnt += (c > 0u) ? 1u : 0u; mine = (j == x) ? c : mine; }
        if (sum == G) break;
        __builtin_amdgcn_s_sleep(1);
        if ((++sp & 255u) == 0u) { if (xb_ld(&bar[XB_TMO])) break; if (sp > XB_SPIN_CAP) { atomicAdd(&bar[XB_TMO], 1u); break; } }
    }
    nloc = mine > 0u ? mine : 1u; nx = cnt > 0u ? cnt : 1u;
}

__device__ __forceinline__ void xcd_barrier(const XcdBarrier& b, bool t0) {
    asm volatile("s_waitcnt vmcnt(0)" ::: "memory");
    __syncthreads();
    if (t0) {
        unsigned* bar = b.bar;
        __builtin_amdgcn_s_waitcnt(0);
        unsigned nloc = b.st[0], nx = b.st[1];
        if (nloc == 0u) { xcd_barrier_complete(bar, b.x, nloc, nx); b.st[0] = nloc; b.st[1] = nx; }
        const unsigned old = xb_add(&bar[XB_XSUB(b.x)], 1u);
        const unsigned gen = old / nloc;
        if (old + 1u == (gen + 1u) * nloc) {
            __builtin_amdgcn_fence(__ATOMIC_RELEASE, "agent");
            asm volatile("s_waitcnt vmcnt(0)" ::: "memory");
            const unsigned og = xb_add(&bar[XB_TOP], 1u);
            const unsigned tg = og / nx;
            if (og + 1u == (tg + 1u) * nx) xb_add(&bar[XB_TOPGEN], 1u);
            else XB_SPIN(xb_ld(&bar[XB_TOPGEN]) == tg, bar);
            __builtin_amdgcn_fence(__ATOMIC_ACQUIRE, "agent");
            xb_add(&bar[XB_XGEN(b.x)], 1u);
            asm volatile("s_waitcnt vmcnt(0)" ::: "memory");
        } else {
            XB_SPIN(xb_ld(&bar[XB_XGEN(b.x)]) == gen, bar);
            __builtin_amdgcn_fence(__ATOMIC_ACQUIRE, "agent");
            asm volatile("s_waitcnt vmcnt(0)" ::: "memory");
        }
    }
    __syncthreads();
}

struct Args { const float* in[12]; float* out; unsigned char* ws; int ph_lo, ph_hi; };
constexpr int N_PHASES = 1 + 4 * DEPTH;
constexpr int I_IN = 16 * 96, I_OUT = 16 * 32;

__global__ void __launch_bounds__(512, 2) fwd(Args a) {
    extern __shared__ __attribute__((aligned(16))) unsigned char lds_raw[];
    LAS unsigned char* lds = (LAS unsigned char*)lds_raw;
    cg::grid_group grid = cg::this_grid();
    const int wave_s = __builtin_amdgcn_readfirstlane(threadIdx.x >> 6);
    const int G = gridDim.x, bx = blockIdx.x;
    const int vcu = (G % 8 == 0) ? (bx % 8) * (G / 8) + bx / 8 : bx;
    const int lo = a.ph_lo, hi = a.ph_hi;
#define WS_PTRS() size_t wso_ = 0; asm volatile("" : "+s"(wso_)); unsigned char* ws = a.ws + wso_;     \
    const int lane = lane_now(), wave = wave_s, tid = (wave_s << 6) | lane; (void)lane; (void)wave; (void)tid; \
    bf16_t* WIN = (bf16_t*)(ws + WS_WIN); bf16_t* WOUT = (bf16_t*)(ws + WS_WOUT); bf16_t* WMEM = (bf16_t*)(ws + WS_WMEM); \
    bf16_t* XB = (bf16_t*)(ws + WS_XB); bf16_t* MEMB = (bf16_t*)(ws + WS_MEMB); bf16_t* QK = (bf16_t*)(ws + WS_QK); bf16_t* VT = (bf16_t*)(ws + WS_VT); \
    bf16_t* KM = (bf16_t*)(ws + WS_KM); bf16_t* VM = (bf16_t*)(ws + WS_VM); bf16_t* GB = (bf16_t*)(ws + WS_G); bf16_t* YB = (bf16_t*)(ws + WS_Y); \
    float* SSQ = (float*)(ws + WS_SSQ); float2* ROPE = (float2*)(ws + WS_ROPE); float* RSX = (float*)(ws + WS_RSX); float* RSM = (float*)(ws + WS_RSM); float* LAM = (float*)(ws + WS_LAM); \
    (void)WIN; (void)WOUT; (void)WMEM; (void)XB; (void)MEMB; (void)QK; (void)VT; (void)KM; (void)VM; (void)GB; (void)YB; (void)SSQ; (void)ROPE; (void)RSX; (void)RSM; (void)LAM;
#define RUN(k) (lo <= (k) && (k) < hi)
#if PROBE_REP == 4
#define SEAM(k) do { if (RUN(k) && RUN((k) + 1)) { xcd_barrier(xbar, wave_s == 0 && lane_now() == 0); xcd_barrier(xbar, wave_s == 0 && lane_now() == 0); } } while (0)
#else
#define SEAM(k) do { if (RUN(k) && RUN((k) + 1)) xcd_barrier(xbar, wave_s == 0 && lane_now() == 0); } while (0)
#endif

    if (threadIdx.x < 2) ((volatile LAS unsigned*)(lds + 131072 + 64))[threadIdx.x] = 0u;
    __syncthreads();
    if (RUN(0)) { WS_PTRS();
        if (bx == 0) for (int i = tid; i < XCD_BAR_WORDS; i += 512) __hip_atomic_store((unsigned*)(ws + WS_BAR) + i, 0u, __ATOMIC_RELAXED, __HIP_MEMORY_SCOPE_AGENT);
        if (bx == 0 && wave < DEPTH) {
            const float* lp = a.in[4] + wave * 128; const int li = lane & 31;
            const float p1 = lp[li] * lp[32 + li], p2 = lp[64 + li] * lp[96 + li];
            const float s1 = wave_sum(lane < 32 ? p1 : 0.f), s2 = wave_sum(lane < 32 ? p2 : 0.f);
            if (lane == 0) LAM[wave] = expf(s1) - expf(s2) + (0.8f - 0.6f * expf(-0.3f * (float)wave));
        }
        LAS float* scr = (LAS float*)(lds + wave * 16384);
        const int gw = vcu * 8 + wave, NGW = G * 8;
        constexpr int I_MEM = 16 * 16, NITEMS0 = DEPTH * I_MEM + I_IN + I_OUT;
#if PROBE_REP == 6
        for (int rep = 0; rep < 2; ++rep) {
#else
        {
#endif
        for (int it = gw; it < NITEMS0; it += NGW) {
            int r = it;
            if (r < DEPTH * I_MEM) { const int l = r / I_MEM; r -= l * I_MEM;
                transpose_item(a.in[9] + (size_t)l * DM * 512, DM, 512, a.in[8] + l * DM, WMEM + (size_t)l * 512 * DM, true, scr, r, lane); continue; }
            r -= DEPTH * I_MEM;
            if (r < I_IN) transpose_item(a.in[3], DM, DIN, a.in[2], WIN, true, scr, r, lane);
            else transpose_item(a.in[10], DM, DM, nullptr, WOUT, false, scr, r - I_IN, lane);
        }
        for (int m = gw; m < MROWS; m += 2 * NGW) rows_update<2>(a.in[0], nullptr, nullptr, nullptr, nullptr, XB, RSX, m, NGW, lane);
        for (int m = gw; m < NB * NMEM; m += NGW) row_update(a.in[1] + (size_t)m * DM, nullptr, nullptr, nullptr, nullptr, MEMB + (size_t)m * DM, RSM + m, lane);
        }
        for (int i = (vcu * 512 + tid); i < 4096 * 16; i += G * 512) rope_entry(i, ROPE + i);

    }
    XcdBarrier xbar; xbar.bar = (unsigned*)(a.ws + WS_BAR); xbar.x = 0; xbar.st = (volatile LAS unsigned*)(lds + 131072 + 64);
    if (RUN(0) && RUN(1)) { grid.sync(); xbar = xcd_barrier_post((unsigned*)(a.ws + WS_BAR), (volatile LAS unsigned*)(lds + 131072 + 64)); }

    for (int l = 0; l < DEPTH; ++l) {
        const int p0 = 1 + 4 * l;
        if (RUN(p0)) { WS_PTRS();
            { pg8::Gemm g{XB, WIN + (size_t)l * DIN * DM, MROWS, DIN, DM}; pg8::StaticOrder S; S.init(MROWS, DIN, G, bx);
              pg8::EpiIn E{RSX, QK, VT, GB, ROPE, a.in[6] + l * 64, a.in[7] + l * 64};
#if PROBE_REP == 1
              for (int rep = 0; rep < 2; ++rep)
#endif
              pg8::gemm_phase<pg8::EpiIn, pg8::StaticOrder, true, true>(lds, g, S, E, wave_s);
            }
            if (l == 0) { pg8::Gemm g{MEMB, WMEM, NB * NMEM, DEPTH * 512, DM}; pg8::StaticOrder S; S.init(NB * NMEM, DEPTH * 512, G, (bx + G - 32) % G);
              pg8::EpiMemKV E{RSM, KM, VM};
              pg8::gemm_phase<pg8::EpiMemKV, pg8::StaticOrder, true, true>(lds, g, S, E, wave_s); }
        }
        SEAM(p0);
        if (RUN(p0 + 1)) { WS_PTRS();
#if PROBE_REP == 2
            for (int rep = 0; rep < 2; ++rep)
#else
            const int rep = 1;
#endif
#if SCHED_XCDHALF
            unsigned redo = 0u;
            for (int safe_pass = 0; safe_pass < 2; ++safe_pass) { int unit_no = 0; if (safe_pass && !redo) break;
            for (int idx = vcu; idx < 768; idx += G) {
                if (idx < 384) { const int bh = idx >> 4, qb = idx & 15, b = bh / 6, h = bh % 6;
                    ATT_CALL(true, lds, QK + ((size_t)(b * 24 + h) * SEQ + qb * 256) * 64, QK + (size_t)(b * 24 + 6 + h) * SEQ * 64, VT + (size_t)(b * 8 + h) * 64 * SEQ, SEQ,
                                         GB + ((size_t)b * SEQ + qb * 256) * DM + h * 64, LAM + l, a.in[5] + l * 64, l, rep == 0, wave_s);
                } else { const int i = idx - 384, bh = i >> 4, qb = i & 15, b = bh / 6, h = bh % 6, kvh = h / 3;
                    ATT_CALL(false, lds, QK + ((size_t)(b * 24 + 12 + h) * SEQ + qb * 256) * 64, QK + (size_t)(b * 24 + 18 + kvh) * SEQ * 64, VT + (size_t)(b * 8 + 6 + kvh) * 64 * SEQ, SEQ,
                                          GB + ((size_t)b * SEQ + qb * 256) * DM + 384 + h * 64, nullptr, nullptr, l, rep == 0, wave_s);
                }
            }
            if (vcu >= 128) for (int k = 0; k < 2; ++k) { const int i = 2 * (vcu - 128) + k, bh = i >> 4, qb = i & 15, b = bh >> 2, h = bh & 3;
                ATT_CALL(false, lds, QK + ((size_t)(b * 24 + 20 + h) * SEQ + qb * 256) * 64, KM + (size_t)((l * 4 + b) * 4 + h) * NMEM * 64, VM + (size_t)((l * 4 + b) * 4 + h) * 64 * NMEM, NMEM,
                                      GB + ((size_t)b * SEQ + qb * 256) * DM + 768 + h * 64, nullptr, nullptr, l, rep == 0, wave_s); }
            }
            const bool light_wg = vcu >= 128; const int light_ix = vcu - 128;
#else
            {
                const int x = vcu >> 5, j = vcu & 31, heavy = j < 16;
                for (int k = 0; k < (heavy ? 2 : 1); ++k) {
                    const int du = heavy ? j + 16 * k : 32 + (j - 16), bh = 3 * x + (du >> 4), qb = du & 15, b = bh / 6, h = bh % 6;
                    ATT_CALL(true, lds, QK + ((size_t)(b * 24 + h) * SEQ + qb * 256) * 64, QK + (size_t)(b * 24 + 6 + h) * SEQ * 64, VT + (size_t)(b * 8 + h) * 64 * SEQ, SEQ,
                                         GB + ((size_t)b * SEQ + qb * 256) * DM + h * 64, LAM + l, a.in[5] + l * 64, l, rep == 0, wave_s);
                }
#if GQA_SPLIT
                { const int b = x >> 1, kvh = x & 1, ng = heavy ? 1 : 5, g0 = heavy ? j : 16 + 5 * (j - 16);
                  for (int k = 0; k < ng; ++k) { const int gu = g0 + k, h = kvh * 3 + (gu >> 5), q128 = gu & 31;
                    att::attn_unit_split(lds, QK + ((size_t)(b * 24 + 12 + h) * SEQ + q128 * 128) * 64, QK + (size_t)(b * 24 + 18 + kvh) * SEQ * 64, VT + (size_t)(b * 8 + 6 + kvh) * 64 * SEQ, SEQ,
                                         GB + ((size_t)b * SEQ + q128 * 128) * DM + 384 + h * 64, rep == 0, wave_s); } }
#else
                { const int b = x >> 1, kvh = x & 1, ng = heavy ? 1 : 2, g0 = heavy ? j : 16 + 2 * (j - 16);
                  for (int k = 0; k < ng; ++k) { const int gu = g0 + k, h = kvh * 3 + (gu >> 4), qb = gu & 15;
                    ATT_CALL(false, lds, QK + ((size_t)(b * 24 + 12 + h) * SEQ + qb * 256) * 64, QK + (size_t)(b * 24 + 18 + kvh) * SEQ * 64, VT + (size_t)(b * 8 + 6 + kvh) * 64 * SEQ, SEQ,
                                         GB + ((size_t)b * SEQ + qb * 256) * DM + 384 + h * 64, nullptr, nullptr, l, rep == 0, wave_s); } }
#endif
                if (GQA_SPLIT ? heavy : !heavy) for (int k = 0; k < 2; ++k) { const int i = x * 32 + 2 * (j & 15) + k, bh = i >> 4, qb = i & 15, b = bh >> 2, h = bh & 3;
                    ATT_CALL(false, lds, QK + ((size_t)(b * 24 + 20 + h) * SEQ + qb * 256) * 64, KM + (size_t)((l * 4 + b) * 4 + h) * NMEM * 64, VM + (size_t)((l * 4 + b) * 4 + h) * 64 * NMEM, NMEM,
                                          GB + ((size_t)b * SEQ + qb * 256) * DM + 768 + h * 64, nullptr, nullptr, l, rep == 0, wave_s); }
            }
            const bool light_wg = (vcu & 31) >= 16; const int light_ix = (vcu >> 5) * 16 + ((vcu & 31) - 16);
#endif
            if (l + 1 < DEPTH && light_wg) {
                __syncthreads();
                LAS float* scr = (LAS float*)(lds + wave * 16384);
                const int lw_ = light_ix * 8 + wave;
                for (int it = lw_; it < I_IN + I_OUT; it += 1024) {
                    if (it < I_IN) transpose_item(a.in[3] + (size_t)(l + 1) * DM * DIN, DM, DIN, a.in[2] + (l + 1) * DM, WIN + (size_t)(l + 1) * DIN * DM, true, scr, it, lane);
                    else transpose_item(a.in[10] + (size_t)(l + 1) * DM * DM, DM, DM, nullptr, WOUT + (size_t)(l + 1) * DM * DM, false, scr, it - I_IN, lane);
                }
            }
        }
        SEAM(p0 + 1);
        if (RUN(p0 + 2)) { WS_PTRS();
            pg8::Gemm g{GB, WOUT + (size_t)l * DM * DM, MROWS, DM, DM}; pg8::StaticOrder S; S.init(MROWS, DM, G, bx);
            pg8::EpiOut E{YB, SSQ};
            pg8::gemm_phase<pg8::EpiOut, pg8::StaticOrder, true, true>(lds, g, S, E, wave_s);
#if PROBE_REP == 3
            pg8::gemm_phase<pg8::EpiOut, pg8::StaticOrder, true, true>(lds, g, S, E, wave_s);
#endif
        }
        SEAM(p0 + 2);
        if (RUN(p0 + 3)) { WS_PTRS();
            const int gw = vcu * 8 + wave, NGW = G * 8;
#if PROBE_REP == 5
            for (int m = gw; m < MROWS; m += NGW)
                row_update(l == 0 ? a.in[0] + (size_t)m * DM : nullptr, YB + (size_t)m * DM, SSQ + (size_t)m * 16, a.in[11] + l * DM, (float*)(ws + WS_QK) + (size_t)m * DM, XB + (size_t)m * DM, (float*)(ws + WS_RSX + 262144) + m, lane);
#endif
            for (int m = gw; m < MROWS; m += 2 * NGW)
                rows_update<2>(l == 0 ? a.in[0] : nullptr, YB, SSQ, a.in[11] + l * DM, l == DEPTH - 1 ? a.out : nullptr, XB, RSX, m, NGW, lane);
        }
        SEAM(p0 + 3);
    }
}

extern "C" void kernel_launch(void* const* d_in, const int* in_sizes, int n_in, void* d_out, int out_size, void* d_ws, size_t ws_size, hipStream_t stream) {
    static int grid = 0;
    if (grid == 0) {
        if (n_in != 12 || ws_size < WS_END) { fprintf(stderr, "kernel_launch: unexpected problem (n_in %d, ws %zu)\n", n_in, ws_size); grid = -1; return; }
        int dev = 0, cus = 0, per_cu = 0;
        hipGetDevice(&dev); hipDeviceGetAttribute(&cus, hipDeviceAttributeMultiprocessorCount, dev);
        if (hipFuncSetAttribute((const void*)fwd, hipFuncAttributeMaxDynamicSharedMemorySize, LDS_BYTES) != hipSuccess) { fprintf(stderr, "kernel_launch: hipFuncSetAttribute failed\n"); grid = -1; return; }
        if (hipOccupancyMaxActiveBlocksPerMultiprocessor(&per_cu, (const void*)fwd, 512, LDS_BYTES) != hipSuccess || per_cu < 1) { fprintf(stderr, "kernel_launch: occupancy query says %d blocks per CU\n", per_cu); per_cu = 1; }
        (void)hipGetLastError();
        grid = 256;
        if (cus < 256) fprintf(stderr, "kernel_launch: %d CUs < 256: the cooperative launch will be refused\n", cus);
    }
    if (grid < 0) return;
    Args a{};
    for (int i = 0; i < 12; ++i) a.in[i] = (const float*)d_in[i];
    a.out = (float*)d_out; a.ws = (unsigned char*)d_ws;
#if ONE_LAUNCH
    a.ph_lo = 0; a.ph_hi = N_PHASES;
    void* args[] = {&a};
    hipError_t e = hipLaunchCooperativeKernel((const void*)fwd, dim3(grid), dim3(512), args, LDS_BYTES, stream);
    if (e != hipSuccess) fprintf(stderr, "kernel_launch: cooperative launch failed: %s (grid %d)\n", hipGetErrorString(e), grid);
#else
    for (int k = 0; k < N_PHASES; ++k) { a.ph_lo = k; a.ph_hi = k + 1; hipLaunchKernelGGL(fwd, dim3(grid), dim3(512), LDS_BYTES, stream, a); }
#endif
}
```
